# Optimizing an MI355X kernel written in HIP

```python
import math
import jax, jax.numpy as jnp
from jax import lax
import numpy as np

D_MODEL = 2048
BATCH = 8
SEQ = 4096
DEPTH = 1
DEC_BATCH = 4
DEC_SEQ = 8192
PAST_LEN = 128

HEAD_DIM = 64
N_HEADS_A = 16
N_KV_HEADS_A = 4
GROUP_A = N_HEADS_A // N_KV_HEADS_A
WINDOW = 128
BLOCK = 128
N_HEADS_B = 8
D_A = N_HEADS_A * HEAD_DIM
D_KV_A = N_KV_HEADS_A * HEAD_DIM
D_B = N_HEADS_B * 2 * HEAD_DIM
D_MIX = D_A + D_B
SPLIT_WIDTHS = [D_A, D_KV_A, D_KV_A, D_A, D_B, D_B, D_B, D_B]
D_IN_PROJ = sum(SPLIT_WIDTHS)
SPLIT_POINTS = [int(c) for c in np.cumsum(SPLIT_WIDTHS)[:-1]]
NUM_BUCKETS = 32
MAX_DISTANCE = 128
EPS = 1e-6

kernel_name = "hymba_swa_sink_diffattn_t5bias_encoder"


def rms_norm(x, g):
    xf = x.astype(jnp.float32)
    y = xf * lax.rsqrt(jnp.mean(xf * xf, axis=-1, keepdims=True) + EPS)
    return (y * g.astype(jnp.float32)).astype(x.dtype)


def t5_bucket(rel):
    half = NUM_BUCKETS // 2
    max_exact = half // 2
    bucket = jnp.where(rel > 0, half, 0)
    n = jnp.abs(rel)
    nf = jnp.maximum(n, 1).astype(jnp.float32)
    large = max_exact + (jnp.log(nf / max_exact) / math.log(MAX_DISTANCE / max_exact)
                         * (half - max_exact)).astype(jnp.int32)
    large = jnp.minimum(large, half - 1)
    return bucket + jnp.where(n < max_exact, n, large)


def window_gqa(q, k, v, sink, rel_bias_a):
    B, S = q.shape[0], q.shape[1]
    nb = S // BLOCK
    qb = q.reshape(B, nb, BLOCK, N_KV_HEADS_A, GROUP_A, HEAD_DIM)
    pad = ((0, 0), (BLOCK, BLOCK), (0, 0), (0, 0))
    kp = jnp.pad(k, pad).reshape(B, nb + 2, BLOCK, N_KV_HEADS_A, HEAD_DIM)
    vp = jnp.pad(v, pad).reshape(B, nb + 2, BLOCK, N_KV_HEADS_A, HEAD_DIM)
    kb = jnp.concatenate([kp[:, :-2], kp[:, 1:-1], kp[:, 2:]], axis=2)
    vb = jnp.concatenate([vp[:, :-2], vp[:, 1:-1], vp[:, 2:]], axis=2)
    s = jnp.einsum('bnqhgd,bnkhd->bnhgqk', qb, kb).astype(jnp.float32) * (HEAD_DIM ** -0.5)
    qi = jnp.arange(BLOCK)[:, None]
    kj = jnp.arange(3 * BLOCK)[None, :]
    rel = kj - BLOCK - qi
    bias = rel_bias_a[t5_bucket(rel)].astype(jnp.float32)
    bias = bias.transpose(2, 0, 1).reshape(N_KV_HEADS_A, GROUP_A, BLOCK, 3 * BLOCK)
    kpos = jnp.arange(nb)[:, None] * BLOCK - BLOCK + kj
    valid = ((jnp.abs(rel) <= WINDOW)[None]
             & ((kpos >= 0) & (kpos < S))[:, None, :])
    s = jnp.where(valid[None, :, None, None], s + bias, -jnp.inf)
    sink_l = jnp.broadcast_to(sink.astype(jnp.float32).reshape(1, 1, N_KV_HEADS_A, GROUP_A, 1, 1),
                              s.shape[:-1] + (1,))
    p = jax.nn.softmax(jnp.concatenate([s, sink_l], axis=-1), axis=-1)[..., :-1]
    o = jnp.einsum('bnhgqk,bnkhd->bnqhgd', p.astype(v.dtype), vb)
    return o.reshape(B, S, D_A)


def diff_attention(q, k, v, lam, lam_init, subln_g, rel_bias_b):
    B, S = q.shape[0], q.shape[1]
    nb = S // BLOCK
    qb = q.reshape(B, nb, BLOCK, N_HEADS_B, 2, HEAD_DIM).transpose(1, 0, 2, 3, 4, 5)
    kpos = jnp.arange(S)
    scale = HEAD_DIM ** -0.5

    def one_block(args):
        qblk, n = args
        s = jnp.einsum('bqhcd,bkhcd->bhcqk', qblk, k).astype(jnp.float32) * scale
        qpos = n * BLOCK + jnp.arange(BLOCK)
        rel = kpos[None, :] - qpos[:, None]
        bias = rel_bias_b[t5_bucket(rel)].astype(jnp.float32).transpose(2, 0, 1)
        p = jax.nn.softmax(s + bias[None, :, None], axis=-1)
        pd = p[:, :, 0] - lam * p[:, :, 1]
        return jnp.einsum('bhqk,bkhe->bqhe', pd.astype(v.dtype), v)

    o = lax.map(one_block, (qb, jnp.arange(nb)))
    o = o.transpose(1, 0, 2, 3, 4).reshape(B, S, N_HEADS_B, 2 * HEAD_DIM)
    o = rms_norm(o, subln_g) * (1.0 - lam_init)
    return o.reshape(B, S, D_B)


def mixer_layer(x, layer_idx, norm_g, w_in, w_out, sink, lq1, lk1, lq2, lk2, subln_g, rel_bias):
    B, S, _ = x.shape
    h = rms_norm(x, norm_g) @ w_in
    qa, ka, va, ga, qb, kb, vb, gb = jnp.split(h, SPLIT_POINTS, axis=-1)
    oa = window_gqa(qa.reshape(B, S, N_HEADS_A, HEAD_DIM),
                    ka.reshape(B, S, N_KV_HEADS_A, HEAD_DIM),
                    va.reshape(B, S, N_KV_HEADS_A, HEAD_DIM),
                    sink, rel_bias[:, :N_HEADS_A])
    lam_init = 0.8 - 0.6 * math.exp(-0.3 * layer_idx)
    lam = (jnp.exp(jnp.sum(lq1.astype(jnp.float32) * lk1.astype(jnp.float32)))
           - jnp.exp(jnp.sum(lq2.astype(jnp.float32) * lk2.astype(jnp.float32))) + lam_init)
    ob = diff_attention(qb.reshape(B, S, N_HEADS_B, 2, HEAD_DIM),
                        kb.reshape(B, S, N_HEADS_B, 2, HEAD_DIM),
                        vb.reshape(B, S, N_HEADS_B, 2 * HEAD_DIM),
                        lam, lam_init, subln_g, rel_bias[:, N_HEADS_A:])
    mixed = jnp.concatenate([jax.nn.silu(ga) * oa, jax.nn.silu(gb) * ob], axis=-1)
    return x + mixed @ w_out


def encode(x, norm_g, w_in, w_out, sink, lambda_q1, lambda_k1, lambda_q2, lambda_k2, subln_g,
           rel_bias, final_g):
    for l in range(DEPTH):
        x = mixer_layer(x, l, norm_g[l], w_in[l], w_out[l], sink[l], lambda_q1[l], lambda_k1[l],
                        lambda_q2[l], lambda_k2[l], subln_g[l], rel_bias)
    return rms_norm(x, final_g)


def setup_inputs(seed: int = 0) -> dict:
    key = jax.random.key(seed)
    ks = jax.random.split(key, 13)
    f32 = jnp.float32
    return {
        "x_prompt": jax.random.normal(ks[0], (BATCH, SEQ, D_MODEL), f32),
        "x_sample": jax.random.normal(ks[1], (DEC_BATCH, DEC_SEQ, D_MODEL), f32),
        "norm_g": 1.0 + 0.05 * jax.random.normal(ks[2], (DEPTH, D_MODEL), f32),
        "w_in": jax.random.normal(ks[3], (DEPTH, D_MODEL, D_IN_PROJ), f32) * D_MODEL ** -0.5,
        "w_out": jax.random.normal(ks[4], (DEPTH, D_MIX, D_MODEL), f32) * D_MIX ** -0.5,
        "sink": 0.5 * jax.random.normal(ks[5], (DEPTH, N_HEADS_A), f32),
        "lambda_q1": 0.1 * jax.random.normal(ks[6], (DEPTH, HEAD_DIM), f32),
        "lambda_k1": 0.1 * jax.random.normal(ks[7], (DEPTH, HEAD_DIM), f32),
        "lambda_q2": 0.1 * jax.random.normal(ks[8], (DEPTH, HEAD_DIM), f32),
        "lambda_k2": 0.1 * jax.random.normal(ks[9], (DEPTH, HEAD_DIM), f32),
        "subln_g": 1.0 + 0.05 * jax.random.normal(ks[10], (DEPTH, 2 * HEAD_DIM), f32),
        "rel_bias": 0.1 * jax.random.normal(ks[11], (NUM_BUCKETS, N_HEADS_A + N_HEADS_B), f32),
        "final_g": 1.0 + 0.05 * jax.random.normal(ks[12], (D_MODEL,), f32),
    }


def reference(x_prompt, x_sample, norm_g, w_in, w_out, sink, lambda_q1, lambda_k1, lambda_q2,
              lambda_k2, subln_g, rel_bias, final_g):
    y_prompt = encode(x_prompt, norm_g, w_in, w_out, sink, lambda_q1, lambda_k1, lambda_q2,
                      lambda_k2, subln_g, rel_bias, final_g)
    y_sample = encode(x_sample, norm_g, w_in, w_out, sink, lambda_q1, lambda_k1, lambda_q2,
                      lambda_k2, subln_g, rel_bias, final_g)
    return (y_prompt, y_sample)
```

```cpp
#include <hip/hip_runtime.h>
#include <hip/hip_cooperative_groups.h>
#include <hip/hip_bf16.h>
#include <cstdio>
#include <cstdint>
#include <cmath>
#define ATT_ABL 0
namespace pg8 {
#define PG8_LAS __attribute__((address_space(3)))
typedef unsigned short bf16_t;
typedef short bf16x8 __attribute__((ext_vector_type(8)));
typedef float f32x4 __attribute__((ext_vector_type(4)));
typedef unsigned u32x4 __attribute__((ext_vector_type(4)));
constexpr int BM = 256, BK = 64, HALF = 128, HTB = HALF * BK * 2  , STAGE_BYTES = 8 * HTB, NXCD = 8, WGM = 8;

__host__ __device__ __forceinline__ int lds_byte(int r, int c) { const int st = (r >> 4) * 2 + (c >> 5), rr = r & 15, cc = c & 31, ob = rr * 64 + cc * 2; return st * 1024 + (ob ^ (((ob >> 9) & 1) << 5)); }
__host__ __device__ __forceinline__ void stage_rc(int b, int& R, int& C) { const int st = b / 1024, sb = b % 1024, swz = sb ^ (((sb >> 9) & 1) << 5); R = (st >> 1) * 16 + swz / 64; C = (st & 1) * 32 + (swz % 64) / 2; }
__host__ __device__ __forceinline__ int perm32(int rho) { const int n = rho >> 4, i = rho & 15; return 8 * (i >> 2) + 4 * n + (i & 3); }

struct Unit { int pm, pn; };
struct Gemm { const bf16_t* A; const bf16_t* Bt; int M, N, K; };

struct StaticOrder {
    int nM, nN, nwg, G, c;
    __host__ __device__ void init(int M, int N, int G_, int c_) { nM = M / BM; nN = N / BM; nwg = nM * nN; G = G_; c = c_; }
    __host__ __device__ bool next(int i, Unit& u) const {
        const long L = (long)i * G + c; if (L >= nwg) return false;
        int wgid = (int)L; { const int q = nwg / NXCD, r = nwg % NXCD, xcd = wgid % NXCD, off = wgid / NXCD; wgid = (xcd < r ? xcd * (q + 1) : r * (q + 1) + (xcd - r) * q) + off; }
        const int nig = WGM * nN, gid = wgid / nig, fm = gid * WGM, gsz = (nM - fm) < WGM ? (nM - fm) : WGM;
        u.pm = fm + ((wgid % nig) % gsz); u.pn = (wgid % nig) / gsz; return true;
    }
    __device__ __forceinline__ void a_ready(const Unit&) const {}
    __device__ __forceinline__ void done(const Unit&) const {}
};
__device__ __forceinline__ unsigned cvt_pk_bf16(float lo, float hi) { unsigned r; asm volatile("v_cvt_pk_bf16_f32 %0, %1, %2" : "=v"(r) : "v"(lo), "v"(hi)); return r; }
typedef float f32x2 __attribute__((ext_vector_type(2)));
struct EpiProj {
    static constexpr bool PERM = true, AFTER_DRAIN = false;
    bf16_t *QA, *KVA, *QKVB, *G; float c2;
    __device__ __forceinline__ void operator()(const f32x4 (&acc)[2][2][4][2], const Unit& u, int wr, int wc, int fr, int fq) const {
        const int row0 = u.pm * BM + wr * 64 + fr; const int colt = u.pn * BM;
        bf16_t* base; int ldc, c0; float sc = 1.f;
        if (colt < 1024)      { base = QA;   ldc = 1024; c0 = colt;        sc = c2; }
        else if (colt < 1536) { base = KVA;  ldc = 512;  c0 = colt - 1024; }
        else if (colt < 2560) { base = G;    ldc = 2048; c0 = colt - 1536; }
        else if (colt < 5632) { base = QKVB; ldc = 3072; c0 = colt - 2560; if (colt < 3584) sc = c2; }
        else                  { base = G;    ldc = 2048; c0 = colt - 5632 + 1024; }
        const int col0 = c0 + wc * 32 + 8 * fq;
#pragma unroll
        for (int ai = 0; ai < 2; ++ai)
#pragma unroll
            for (int m = 0; m < 4; ++m) { bf16_t* rowp = base + (size_t)(row0 + ai * HALF + m * 16) * ldc + col0;
#pragma unroll
                for (int bj = 0; bj < 2; ++bj) { f32x4 v0 = acc[ai][bj][m][0] * sc, v1 = acc[ai][bj][m][1] * sc;
                    u32x4 w; w.x = cvt_pk_bf16(v0[0], v0[1]); w.y = cvt_pk_bf16(v0[2], v0[3]); w.z = cvt_pk_bf16(v1[0], v1[1]); w.w = cvt_pk_bf16(v1[2], v1[3]);
                    *(u32x4*)(rowp + bj * HALF) = w; } }
    }
};
struct EpiRes {
    static constexpr bool PERM = true, AFTER_DRAIN = false;
    const float* xp; const float* xs; bf16_t* zb; float* part;
    __device__ __forceinline__ void operator()(const f32x4 (&acc)[2][2][4][2], const Unit& u, int wr, int wc, int fr, int fq) const {
        const int col0 = u.pn * BM + wc * 32 + 8 * fq;
#pragma unroll
        for (int ai = 0; ai < 2; ++ai)
#pragma unroll
            for (int m = 0; m < 4; ++m) { const int row = u.pm * BM + ai * HALF + wr * 64 + m * 16 + fr;
                const float* xr = (row < 32768 ? xp + (size_t)row * 2048 : xs + (size_t)(row - 32768) * 2048) + col0; bf16_t* zrow = zb + (size_t)row * 2048 + col0;
                float s = 0.f;
#pragma unroll
                for (int bj = 0; bj < 2; ++bj) { const f32x4 v0 = *(const f32x4*)(xr + bj * HALF) + acc[ai][bj][m][0], v1 = *(const f32x4*)(xr + bj * HALF + 4) + acc[ai][bj][m][1];
                    s += ((v0[0] * v0[0] + v0[1] * v0[1]) + (v0[2] * v0[2] + v0[3] * v0[3])) + ((v1[0] * v1[0] + v1[1] * v1[1]) + (v1[2] * v1[2] + v1[3] * v1[3]));
                    u32x4 w; w.x = cvt_pk_bf16(v0[0], v0[1]); w.y = cvt_pk_bf16(v0[2], v0[3]); w.z = cvt_pk_bf16(v1[0], v1[1]); w.w = cvt_pk_bf16(v1[2], v1[3]);
                    *(u32x4*)(zrow + bj * HALF) = w; }
                s += __shfl_xor(s, 16); s += __shfl_xor(s, 32);
                if (fq == 0) part[(size_t)row * 32 + u.pn * 4 + wc] = s; }
    }
};
template <class Epi, class Sched, bool ALIGN_EPI = false, bool SP2 = false>
__device__ __forceinline__ void gemm_phase(PG8_LAS unsigned char* lds, const Gemm g, const Sched& S, const Epi& E) {
    int tid_ = threadIdx.x; asm volatile("" : "+v"(tid_));
    const int tid = tid_, wid = __builtin_amdgcn_readfirstlane(tid >> 6), lane = tid & 63, wr = wid >> 2, wc = wid & 3, fr = lane & 15, fq = lane >> 4;
    const int K = g.K, nt = K / BK;
    unsigned voffA[2], voffB[2];
#pragma unroll
    for (int i = 0; i < 2; ++i) { int R, C; stage_rc(tid * 16 + i * 8192, R, C); const int Rb = Epi::PERM ? ((R & ~31) + perm32(R & 31)) : R;
        voffA[i] = (unsigned)(R * K + C) * 2u; voffB[i] = (unsigned)(Rb * K + C) * 2u; }
    const size_t kstep = (size_t)(BK * 2);
    const size_t hstep = (size_t)HALF * K * 2;
    const size_t tstep = 2 * hstep;
    const unsigned ldsw = (unsigned)wid * 1024u;
    const int aoff = lds_byte(wr * 64 + fr, fq * 8), boff = lds_byte(wc * 32 + fr, fq * 8);
#define PG8_SA(b, h) (((b) * 2 + (h)) * HTB)
#define PG8_SB(b, h) ((4 + (b) * 2 + (h)) * HTB)
#define PG8_STAGE(bufoff, gbase, voff) do { _Pragma("unroll") for (int _i = 0; _i < 2; ++_i) \
        __builtin_amdgcn_global_load_lds((const unsigned*)((const char*)(gbase) + (voff)[_i]), (PG8_LAS unsigned*)(lds + (bufoff) + ldsw + _i * 8192), 16, 0, 0); } while (0)
#define PG8_LDA(dst, b, h) do { _Pragma("unroll") for (int m = 0; m < 4; ++m) _Pragma("unroll") for (int k = 0; k < 2; ++k) dst[m][k] = *(const PG8_LAS bf16x8*)(lds + PG8_SA(b, h) + aoff + m * 2048 + k * 1024); } while (0)
#define PG8_LDB(dst, b, h) do { _Pragma("unroll") for (int n = 0; n < 2; ++n) _Pragma("unroll") for (int k = 0; k < 2; ++k) dst[n][k] = *(const PG8_LAS bf16x8*)(lds + PG8_SB(b, h) + boff + n * 2048 + k * 1024); } while (0)
#define PG8_MMA(ai, bj, At, Bt) do { __builtin_amdgcn_s_setprio(1); _Pragma("unroll") for (int m = 0; m < 4; ++m) _Pragma("unroll") for (int n = 0; n < 2; ++n) _Pragma("unroll") for (int k = 0; k < 2; ++k) \
        acc[ai][bj][m][n] = __builtin_amdgcn_mfma_f32_16x16x32_bf16(Bt[n][k], At[m][k], acc[ai][bj][m][n], 0, 0, 0); __builtin_amdgcn_s_setprio(0); } while (0)
#define PG8_WAIT_V(n) asm volatile("s_waitcnt vmcnt(" #n ")" ::: "memory")
#define PG8_WAIT_L(n) asm volatile("s_waitcnt lgkmcnt(" #n ")" ::: "memory")
#define PG8_BAR __builtin_amdgcn_s_barrier()
#define PG8_SCHED __builtin_amdgcn_sched_barrier(0)
    Unit cur, nxt; int ui = 0;
    if (!S.next(0, cur)) return;
    f32x4 acc[2][2][4][2];
#pragma unroll
    for (int a = 0; a < 2; ++a)
#pragma unroll
        for (int b = 0; b < 2; ++b)
#pragma unroll
            for (int m = 0; m < 4; ++m)
#pragma unroll
                for (int n = 0; n < 2; ++n) acc[a][b][m][n] = (f32x4){0.f, 0.f, 0.f, 0.f};
    bf16x8 At[4][2], B0[2][2], B1[2][2];
    const char* cA = (const char*)g.A + (size_t)cur.pm * tstep; const char* cB = (const char*)g.Bt + (size_t)cur.pn * tstep;
    S.a_ready(cur);
    if constexpr (SP2) {
        PG8_STAGE(PG8_SB(0, 0), cB, voffB); PG8_STAGE(PG8_SB(0, 1), cB + hstep, voffB); PG8_STAGE(PG8_SA(0, 0), cA, voffA); PG8_STAGE(PG8_SA(0, 1), cA + hstep, voffA);
        if (wr == 1) PG8_BAR;
        PG8_WAIT_V(2); PG8_BAR;
        PG8_STAGE(PG8_SB(1, 0), cB + kstep, voffB); PG8_STAGE(PG8_SA(1, 0), cA + kstep, voffA); PG8_STAGE(PG8_SB(1, 1), cB + hstep + kstep, voffB);
        PG8_WAIT_V(6); PG8_BAR;
    } else {
        PG8_STAGE(PG8_SB(0, 0), cB, voffB); PG8_STAGE(PG8_SA(0, 0), cA, voffA); PG8_STAGE(PG8_SB(0, 1), cB + hstep, voffB); PG8_STAGE(PG8_SA(0, 1), cA + hstep, voffA);
        if (wr == 1) PG8_BAR;
        PG8_WAIT_V(4); PG8_BAR;
        PG8_STAGE(PG8_SB(1, 0), cB + kstep, voffB); PG8_STAGE(PG8_SA(1, 0), cA + kstep, voffA); PG8_STAGE(PG8_SB(1, 1), cB + hstep + kstep, voffB);
        PG8_WAIT_V(6); PG8_BAR;
    }
    for (;;) {
        const bool has_next = S.next(ui + 1, nxt);
        const char* nA = has_next ? (const char*)g.A + (size_t)nxt.pm * tstep : cA; const char* nB = has_next ? (const char*)g.Bt + (size_t)nxt.pn * tstep : cB;
        for (int t = 0; t < nt; t += 2) {
            const bool last = (t == nt - 2);
            const char* a1 = cA + (size_t)(t + 1) * kstep;
            const char* a2 = last ? nA : cA + (size_t)(t + 2) * kstep; const char* b2 = last ? nB : cB + (size_t)(t + 2) * kstep;
            const char* a3 = a2 + kstep; const char* b3 = b2 + kstep;
            if (last && has_next) S.a_ready(nxt);
            if constexpr (SP2) {
            PG8_LDB(B0, 0, 0); PG8_LDB(B1, 0, 1); PG8_SCHED; PG8_LDA(At, 0, 0); PG8_STAGE(PG8_SA(1, 1), a1 + hstep, voffA);
            PG8_WAIT_V(8); PG8_WAIT_L(0); PG8_BAR; PG8_MMA(0, 0, At, B0); PG8_MMA(0, 1, At, B1); PG8_BAR; PG8_SCHED;
            PG8_LDA(At, 0, 1); PG8_STAGE(PG8_SB(0, 0), b2, voffB); PG8_STAGE(PG8_SB(0, 1), b2 + hstep, voffB); PG8_STAGE(PG8_SA(0, 0), a2, voffA);
            PG8_WAIT_V(8); PG8_WAIT_L(0); PG8_BAR; PG8_MMA(1, 0, At, B0); PG8_MMA(1, 1, At, B1); PG8_BAR; PG8_SCHED;
            PG8_LDB(B0, 1, 0); PG8_LDB(B1, 1, 1); PG8_SCHED; PG8_LDA(At, 1, 0); PG8_STAGE(PG8_SA(0, 1), a2 + hstep, voffA);
            PG8_WAIT_V(8); PG8_WAIT_L(0); PG8_BAR; PG8_MMA(0, 0, At, B0); PG8_MMA(0, 1, At, B1); PG8_BAR; PG8_SCHED;
            PG8_LDA(At, 1, 1); PG8_STAGE(PG8_SB(1, 0), b3, voffB); PG8_STAGE(PG8_SB(1, 1), b3 + hstep, voffB); PG8_STAGE(PG8_SA(1, 0), a3, voffA);
            PG8_WAIT_V(8); PG8_WAIT_L(0); PG8_BAR; PG8_MMA(1, 0, At, B0); PG8_MMA(1, 1, At, B1); PG8_BAR; PG8_SCHED;
            } else {
            PG8_LDB(B0, 0, 0); PG8_SCHED; PG8_LDA(At, 0, 0); PG8_STAGE(PG8_SA(1, 1), a1 + hstep, voffA);
            PG8_WAIT_L(8); PG8_BAR; PG8_WAIT_L(0); PG8_MMA(0, 0, At, B0); PG8_BAR; PG8_SCHED;
            PG8_LDB(B1, 0, 1); PG8_STAGE(PG8_SB(0, 0), b2, voffB);
            PG8_BAR; PG8_WAIT_L(0); PG8_MMA(0, 1, At, B1); PG8_BAR;
            PG8_LDA(At, 0, 1); PG8_STAGE(PG8_SA(0, 0), a2, voffA);
            PG8_BAR; PG8_WAIT_L(0); PG8_MMA(1, 0, At, B0); PG8_BAR; PG8_SCHED;
            PG8_STAGE(PG8_SB(0, 1), b2 + hstep, voffB);
            PG8_WAIT_V(6); PG8_BAR; PG8_MMA(1, 1, At, B1); PG8_BAR;
            PG8_LDB(B0, 1, 0); PG8_SCHED; PG8_LDA(At, 1, 0); PG8_STAGE(PG8_SA(0, 1), a2 + hstep, voffA);
            PG8_WAIT_L(8); PG8_BAR; PG8_WAIT_L(0); PG8_MMA(0, 0, At, B0); PG8_BAR; PG8_SCHED;
            PG8_LDB(B1, 1, 1); PG8_STAGE(PG8_SB(1, 0), b3, voffB);
            PG8_BAR; PG8_WAIT_L(0); PG8_MMA(0, 1, At, B1); PG8_BAR;
            PG8_LDA(At, 1, 1); PG8_STAGE(PG8_SA(1, 0), a3, voffA);
            PG8_BAR; PG8_WAIT_L(0); PG8_MMA(1, 0, At, B0); PG8_BAR; PG8_SCHED;
            PG8_STAGE(PG8_SB(1, 1), b3 + hstep, voffB);
            PG8_WAIT_V(6); PG8_BAR; PG8_MMA(1, 1, At, B1); PG8_BAR;
            }
        }
        if constexpr (ALIGN_EPI) { if (wr == 0) PG8_BAR; }
        if constexpr (!Epi::AFTER_DRAIN) { E(acc, cur, wr, wc, fr, fq); S.done(cur); }
        if (!has_next) break;
#pragma unroll
        for (int a = 0; a < 2; ++a)
#pragma unroll
            for (int b = 0; b < 2; ++b)
#pragma unroll
                for (int m = 0; m < 4; ++m)
#pragma unroll
                    for (int n = 0; n < 2; ++n) acc[a][b][m][n] = (f32x4){0.f, 0.f, 0.f, 0.f};
        cur = nxt; cA = nA; cB = nB; ++ui;
        if constexpr (ALIGN_EPI) { if (wr == 1) PG8_BAR; }
    }
    PG8_WAIT_V(0);
    if constexpr (!ALIGN_EPI) { if (wr == 0) PG8_BAR; }
    PG8_BAR;
    if constexpr (Epi::AFTER_DRAIN) { E.fused(acc, cur, wr, wc, fr, fq, lds, wid, lane); S.done(cur); }
#undef PG8_SA
#undef PG8_SB
#undef PG8_STAGE
#undef PG8_LDA
#undef PG8_LDB
#undef PG8_MMA
#undef PG8_WAIT_V
#undef PG8_WAIT_L
#undef PG8_BAR
#undef PG8_SCHED
}
}
namespace att {
#define LAS3 __attribute__((address_space(3)))
typedef LAS3 const char* lds_cptr;
typedef unsigned short bf16_t;
using bf16x8 = __attribute__((ext_vector_type(8))) short;
using s16x4 = __attribute__((ext_vector_type(4))) short;
using f32x16 = __attribute__((ext_vector_type(16))) float;
using u32x4 = __attribute__((ext_vector_type(4))) unsigned;
typedef short v4i16_t __attribute__((ext_vector_type(4)));
constexpr int SLOTB = 32768, NSLOT = 4, OFF_K2 = 8192, OFF_V = 16384;
constexpr int LDS_WS = NSLOT * SLOTB;
constexpr int LDS_TAB = LDS_WS + 2048;
constexpr int LDS_END = LDS_TAB + 9216;
constexpr int TABW = 576, TAB0 = 288;
constexpr float LOG2E = 1.4426950408889634f;
constexpr float C2 = 0.125f * LOG2E;
constexpr float THRL = 8.0f;
__device__ __forceinline__ int crow(int r, int hi) { return (r & 3) + 8 * (r >> 2) + 4 * hi; }
template <int OFF> __device__ __forceinline__ void glds16o(const void* gsrc, unsigned lds_dst) { unsigned keep;
  asm volatile("s_mov_b32 %0, m0\n\ts_mov_b32 m0, %2\n\ts_nop 0\n\tglobal_load_lds_dwordx4 %1, off offset:%c3\n\ts_mov_b32 m0, %0" : "=&s"(keep) : "v"(gsrc), "s"(lds_dst - (unsigned)OFF), "i"(OFF) : "memory"); }
__device__ __forceinline__ void glds16(const void* gsrc, unsigned lds_dst) { unsigned keep;
  asm volatile("s_mov_b32 %0, m0\n\ts_mov_b32 m0, %2\n\ts_nop 0\n\tglobal_load_lds_dwordx4 %1, off\n\ts_mov_b32 m0, %0" : "=&s"(keep) : "v"(gsrc), "s"(lds_dst) : "memory"); }
typedef float f32x2_t __attribute__((ext_vector_type(2))); typedef __bf16 bf16x2_t __attribute__((ext_vector_type(2)));
__device__ __forceinline__ unsigned cvtpk(float lo, float hi) { f32x2_t v = {lo, hi}; bf16x2_t b = __builtin_convertvector(v, bf16x2_t); return __builtin_bit_cast(unsigned, b); }
__device__ __forceinline__ float bf2f(bf16_t v) { return __uint_as_float((unsigned)v << 16); }
__device__ __forceinline__ bf16_t f2bf(float f) { return (bf16_t)(cvtpk(f, 0.f) & 0xffffu); }
__device__ __forceinline__ float max2f(float a, float b) { float r; asm("v_max_f32_e32 %0, %1, %2" : "=v"(r) : "v"(a), "v"(b)); return r; }
__device__ __forceinline__ float max3f(float a, float b, float c) { float r; asm("v_max3_f32 %0, %1, %2, %3" : "=v"(r) : "v"(a), "v"(b), "v"(c)); return r; }
#define ATT_WAIT_BAR(N) asm volatile("s_waitcnt vmcnt(" #N ") lgkmcnt(0)\n\ts_barrier" ::: "memory")
__device__ __forceinline__ s16x4 vtr(lds_cptr p) { return __builtin_bit_cast(s16x4, __builtin_amdgcn_ds_read_tr16_b64_v4i16((LAS3 v4i16_t*)p)); }

struct Tensors { bf16_t* QA; bf16_t* KVA; bf16_t* QKVB; bf16_t* G; const float* gtab; const float* sink; const float* subg; const float* lamp; };

template <int MODE>
__device__ __forceinline__ void attn_unit(const Tensors& T0, int ureq, int b, int hh, int qblk, LAS3 char* shm, const bool dummy = false) {
  constexpr int ND = MODE ? 4 : 2;
  constexpr int QROWS = MODE ? 128 : 64;
  constexpr int PQ = MODE ? 3072 : 1024, PK = MODE ? 3072 : 512;
  int tid = threadIdx.x; asm volatile("" : "+v"(tid));
  Tensors T = T0;
  asm volatile("" : "+s"(T.QA), "+s"(T.KVA), "+s"(T.QKVB), "+s"(T.G)); asm volatile("" : "+s"(T.gtab), "+s"(T.sink), "+s"(T.subg), "+s"(T.lamp));
  const int lane = tid & 63, r32 = lane & 31, hi = lane >> 5; const int wid = __builtin_amdgcn_readfirstlane(tid >> 6);
  const int S = ureq ? 8192 : 4096;
  const long rowbase = ureq ? 32768 + (long)b * 8192 : (long)b * 4096;
  const int rg = MODE ? (wid & 3) : (wid & 1);
  const int sub = MODE ? (wid >> 2) : (wid >> 1);
  const int Q0 = qblk * QROWS, q0w = Q0 + rg * 32;
  const bf16_t* Qw = MODE ? T.QKVB + (rowbase + q0w) * PQ + hh * 128 + sub * 64 : T.QA + (rowbase + q0w) * PQ + (hh * 4 + sub) * 64;
  const bf16_t* Kh = MODE ? T.QKVB + rowbase * PK + 1024 + hh * 128 : T.KVA + rowbase * PK + hh * 64;
  const bf16_t* Vh = MODE ? T.QKVB + rowbase * PK + 2048 + hh * 128 : T.KVA + rowbase * PK + 256 + hh * 64;
  const unsigned lds0 = (unsigned)(uintptr_t)shm;
  LAS3 float* wsf = (LAS3 float*)(shm + LDS_WS) + wid * 64;
  LAS3 float* tab = (LAS3 float*)(shm + LDS_TAB);
  { const float* gt = T.gtab + (MODE ? (16 + hh) : hh * 4) * TABW; for (int i = tid; i < (MODE ? 1 : 4) * TABW; i += 512) tab[i] = gt[i]; }
  float cbL = 0.f, cbR = 0.f, lam = 0.f, sinkv = 0.f;
  if (MODE) { cbL = T.gtab[(16 + hh) * TABW]; cbR = T.gtab[(16 + hh) * TABW + TABW - 1]; lam = T.lamp[0]; } else { sinkv = T.sink[hh * 4 + sub] * LOG2E; }
  bf16x8 qr[4];
#pragma unroll
  for (int d0 = 0; d0 < 4; ++d0) qr[d0] = *reinterpret_cast<const bf16x8*>(&Qw[(long)r32 * PQ + d0 * 16 + hi * 8]);
  asm volatile("s_waitcnt vmcnt(0)" ::: "memory");
  const int drow = 8 * wid + (lane >> 3);
  const bf16_t* ksrc = Kh + (long)drow * PK + (((lane & 7) ^ ((drow >> 1) & 7)) * 8);
  const bf16_t* vsrc = Vh + (long)drow * PK + ((((lane >> 2) & 1) ^ ((lane >> 4) & 1)) * 32) + (lane & 3) * 8;
  const unsigned dwv = lds0 + wid * 1024;
#define ATT_DMA(t, so) do { const long _o = (long)(t) * 64 * PK; const bf16_t* const kq_ = ksrc + _o; const bf16_t* const vq2_ = vsrc + _o;     \
    glds16o<0>(kq_, (unsigned)__builtin_amdgcn_readfirstlane(dwv + (so))); \
    if (MODE) glds16o<128>(kq_, (unsigned)__builtin_amdgcn_readfirstlane(dwv + (so) + OFF_K2)); \
    glds16o<0>(vq2_, (unsigned)__builtin_amdgcn_readfirstlane(dwv + (so) + OFF_V)); \
    if (MODE) glds16o<128>(vq2_, (unsigned)__builtin_amdgcn_readfirstlane(dwv + (so) + OFF_V + 8192)); } while (0)
  int t_lo = 0, t_hi = S / 64;
  if (!MODE) { t_lo = (Q0 >= 128 ? Q0 - 128 : 0) / 64; const int e = Q0 + 64 + 128; t_hi = (e < S ? e : S) / 64; }
  const int NT = t_hi - t_lo;
  const int grp = wid >> 2;
  lds_cptr kp[4];
#pragma unroll
  for (int d0 = 0; d0 < 4; ++d0) kp[d0] = (lds_cptr)shm + (MODE ? sub * OFF_K2 : 0) + r32 * 128 + (((2 * d0 + hi) ^ ((r32 >> 1) & 7)) << 4);
  const int vrow = 4 * hi + ((lane & 15) >> 2), vsw = (lane >> 3) & 1;
  const lds_cptr vpe = (lds_cptr)shm + OFF_V + vrow * 128 + vsw * 64 + ((lane >> 4) & 1) * 32 + (lane & 3) * 8;
  const lds_cptr vpo = (lds_cptr)shm + OFF_V + vrow * 128 + (vsw ^ 1) * 64 + ((lane >> 4) & 1) * 32 + (lane & 3) * 8;
  float mhat, l_reg, curcb; bool first; f32x16 o[ND]; f32x16 negm; u32x4 pw[4];
#define ATT_BAR_V(full) do { if (full) { if (MODE) ATT_WAIT_BAR(4); else ATT_WAIT_BAR(2); } else ATT_WAIT_BAR(0); } while (0)
#define ATT_BAR_L() asm volatile("s_waitcnt lgkmcnt(0)\n\ts_barrier" ::: "memory")
#define ATT_SB() __builtin_amdgcn_sched_barrier(0)
#define ATT_VREAD(buf, ks, vso) do { _Pragma("unroll") for (int d0 = 0; d0 < ND; ++d0) { const lds_cptr vq_ = ((d0 & 1) ? vpo : vpe) + (vso) + (d0 >> 1) * 8192 + (ks) * 2048; \
      const s16x4 lo = vtr(vq_), hi4 = vtr(vq_ + 1024); \
      buf[d0] = (bf16x8){lo[0], lo[1], lo[2], lo[3], hi4[0], hi4[1], hi4[2], hi4[3]}; } } while (0)
#define ATT_PVK(buf, ks) do { _Pragma("unroll") for (int d0 = 0; d0 < ND; ++d0) \
      o[d0] = __builtin_amdgcn_mfma_f32_32x32x16_bf16(__builtin_bit_cast(bf16x8, pw[ks]), buf[d0], o[d0], 0, 0, 0); } while (0)
#define ATT_VREAD1(buf, d0, ks, vso) do { const lds_cptr vq_ = (((d0) & 1) ? vpo : vpe) + (vso) + ((d0) >> 1) * 8192 + (ks) * 2048; \
      const s16x4 lo = vtr(vq_), hi4 = vtr(vq_ + 1024); buf[d0] = (bf16x8){lo[0], lo[1], lo[2], lo[3], hi4[0], hi4[1], hi4[2], hi4[3]}; } while (0)
#define ATT_PVK_RD(buf, ks, vp) do { _Pragma("unroll") for (int d0 = 0; d0 < ND; ++d0) { \
      o[d0] = __builtin_amdgcn_mfma_f32_32x32x16_bf16(__builtin_bit_cast(bf16x8, pw[ks]), buf[d0], o[d0], 0, 0, 0); ATT_VREAD1(buf, d0, (ks) + 2, vp); ATT_SB(); } } while (0)
#define ATT_PV_REST(vp) do { ATT_PVK_RD(vA, 0, vp); ATT_PVK_RD(vB, 1, vp); ATT_PVK(vA, 2); ATT_PVK(vB, 3); } while (0)
  bf16x8 vA[ND], vB[ND];
  mhat = MODE ? 0.f : sinkv; l_reg = (!MODE && hi == 0) ? 1.f : 0.f; curcb = 0.f; first = MODE ? true : false;
#pragma unroll
  for (int d = 0; d < ND; ++d) o[d] = f32x16{};
#pragma unroll
  for (int r = 0; r < 16; ++r) negm[r] = -mhat;
#pragma unroll
  for (int j = 0; j < 4; ++j) pw[j] = (u32x4){0u, 0u, 0u, 0u};
  if (!(ATT_ABL == 2 && dummy)) { ATT_DMA(t_lo, 0); ATT_DMA(t_lo + 1, SLOTB); }
  ATT_BAR_V(true);
  if (grp == 1) { if (NT > 2 && !(ATT_ABL == 2 && dummy)) ATT_DMA(t_lo + 2, 2 * SLOTB); ATT_BAR_L(); }
  for (int i = 0; i < NT; ++i) {
    const int t = t_lo + i;
    const int k0 = t * 64;
    float cb = 0.f; bool near = true;
    if (MODE) { if (k0 + 63 - Q0 <= -91) { cb = cbL; near = false; } else if (k0 - (Q0 + 127) >= 91) { cb = cbR; near = false; } }
    if (cb != curcb) { curcb = cb;
#pragma unroll
      for (int r = 0; r < 16; ++r) negm[r] = cb - mhat; }
    f32x16 C0 = negm, C1 = negm;
    if (!(ATT_ABL == 4 && dummy)) { const int kso = (i & 3) * SLOTB; const int vp = ((i - 1) & 3) * SLOTB;
      bf16x8 kf[8];
#pragma unroll
      for (int d0 = 0; d0 < 2; ++d0) { kf[2 * d0] = *(const LAS3 bf16x8*)(kp[d0] + kso); kf[2 * d0 + 1] = *(const LAS3 bf16x8*)(kp[d0] + kso + 4096); }
      if (i > 0) { ATT_VREAD(vB, 1, vp); }
      ATT_SB();
      if (i > 0) { ATT_PVK_RD(vA, 0, vp); }
      C0 = __builtin_amdgcn_mfma_f32_32x32x16_bf16(kf[0], qr[0], negm, 0, 0, 0); C1 = __builtin_amdgcn_mfma_f32_32x32x16_bf16(kf[1], qr[0], negm, 0, 0, 0);
      C0 = __builtin_amdgcn_mfma_f32_32x32x16_bf16(kf[2], qr[1], C0, 0, 0, 0); C1 = __builtin_amdgcn_mfma_f32_32x32x16_bf16(kf[3], qr[1], C1, 0, 0, 0);
      ATT_SB();
#pragma unroll
      for (int d0 = 2; d0 < 4; ++d0) { kf[2 * d0] = *(const LAS3 bf16x8*)(kp[d0] + kso); kf[2 * d0 + 1] = *(const LAS3 bf16x8*)(kp[d0] + kso + 4096); }
      ATT_SB();
      if (i > 0) { ATT_PVK_RD(vB, 1, vp); }
#pragma unroll
      for (int d0 = 2; d0 < 4; ++d0) { C0 = __builtin_amdgcn_mfma_f32_32x32x16_bf16(kf[2 * d0], qr[d0], C0, 0, 0, 0); C1 = __builtin_amdgcn_mfma_f32_32x32x16_bf16(kf[2 * d0 + 1], qr[d0], C1, 0, 0, 0); }
      ATT_SB();
      if (i > 0) { ATT_PVK(vA, 2); ATT_PVK(vB, 3); } }
    asm volatile("" : "+v"(C0), "+v"(C1));
#pragma unroll
    for (int d = 0; d < ND; ++d) asm volatile("" : "+v"(o[d]));
    if (grp == 0) ATT_BAR_L(); else ATT_BAR_V(i + 2 < NT);
    if (i == 0) asm volatile("s_nop 15\n\ts_nop 7" : "+v"(C0), "+v"(C1));
    else asm volatile("" : "+v"(C0), "+v"(C1));
    ATT_VREAD(vA, 0, (i & 3) * SLOTB); ATT_SB();
    if (grp == 0 && i + 2 < NT && !(ATT_ABL == 2 && dummy)) ATT_DMA(t + 2, ((i + 2) & 3) * SLOTB);
    if (grp == 1 && i + 3 < NT && !(ATT_ABL == 2 && dummy)) ATT_DMA(t + 3, ((i + 3) & 3) * SLOTB);
    if (!(ATT_ABL == 3 && dummy)) {
    if (near) {
      const LAS3 float* tp = tab + (MODE ? 0 : sub * TABW) + (k0 - q0w - r32 + 4 * hi + TAB0);
#pragma unroll
      for (int r = 0; r < 16; ++r) { C0[r] += tp[(r & 3) + 8 * (r >> 2)]; C1[r] += tp[(r & 3) + 8 * (r >> 2) + 32]; }
    }
    float rm;
    { float a = max3f(C0[0], C0[1], C1[0]), bq = max3f(C0[2], C0[3], C1[1]); a = max3f(a, C1[2], C1[3]);
#pragma unroll
      for (int r = 4; r < 16; r += 4) { a = max3f(a, C0[r], C0[r + 1]); bq = max3f(bq, C0[r + 2], C0[r + 3]); a = max3f(a, C1[r], C1[r + 1]); bq = max3f(bq, C1[r + 2], C1[r + 3]); }
      a = max2f(a, bq);
      auto rr = __builtin_amdgcn_permlane32_swap(__float_as_uint(a), __float_as_uint(a), false, false);
      rm = max2f(__uint_as_float(rr[0]), __uint_as_float(rr[1])); }
    if (first || __any(rm > THRL)) {
      const float dl = first ? rm : __builtin_fmaxf(rm, 0.f);
      mhat += dl;
#pragma unroll
      for (int r = 0; r < 16; ++r) { C0[r] -= dl; C1[r] -= dl; negm[r] = curcb - mhat; }
      if (!first) {
        const float f = __builtin_amdgcn_exp2f(-dl); l_reg *= f;
        if (hi == 0) wsf[r32] = f;
        asm volatile("s_waitcnt lgkmcnt(0)" ::: "memory");
#pragma unroll
        for (int r = 0; r < 16; ++r) { const float fr_ = wsf[crow(r, hi)];
#pragma unroll
          for (int d = 0; d < ND; ++d) o[d][r] *= fr_; }
      }
      first = false;
    }
    float sacc = 0.f;
#pragma unroll
    for (int r = 0; r < 16; ++r) { C0[r] = __builtin_amdgcn_exp2f(C0[r]); C1[r] = __builtin_amdgcn_exp2f(C1[r]); sacc += C0[r] + C1[r]; }
    l_reg += sacc;
#pragma unroll
    for (int j = 0; j < 4; ++j) { pw[0][j] = cvtpk(C0[2 * j], C0[2 * j + 1]); pw[1][j] = cvtpk(C0[8 + 2 * j], C0[8 + 2 * j + 1]);
                                  pw[2][j] = cvtpk(C1[2 * j], C1[2 * j + 1]); pw[3][j] = cvtpk(C1[8 + 2 * j], C1[8 + 2 * j + 1]); }
    }
    asm volatile("" : "+v"(pw[0]), "+v"(pw[1]), "+v"(pw[2]), "+v"(pw[3]), "+v"(l_reg));
    if (grp == 0) ATT_BAR_V(i + 2 < NT); else if (i + 1 < NT) ATT_BAR_L();
  }
  { const int vp = ((NT - 1) & 3) * SLOTB; ATT_VREAD(vB, 1, vp); ATT_SB(); ATT_PV_REST(vp); }
#undef ATT_VREAD
#undef ATT_PVK
#undef ATT_PV_REST
#undef ATT_VREAD1
#undef ATT_PVK_RD
#undef ATT_SB
#undef ATT_BAR_V
#undef ATT_BAR_L
#undef ATT_DMA
  { auto rr = __builtin_amdgcn_permlane32_swap(__float_as_uint(l_reg), __float_as_uint(l_reg), false, false); l_reg = __uint_as_float(rr[0]) + __uint_as_float(rr[1]); }
  if (hi == 0) wsf[32 + r32] = l_reg;
  asm volatile("s_waitcnt lgkmcnt(0)" ::: "memory");
  float rli[16];
#pragma unroll
  for (int r = 0; r < 16; ++r) rli[r] = 1.0f / wsf[32 + crow(r, hi)];
  if (MODE) {
    bf16_t* const gpb = T.G + (size_t)(rowbase + q0w) * 2048 + 1024 + hh * 128 + r32;
    bf16_t gv[2][16];
    if (sub == 0 && !dummy) {
#pragma unroll
      for (int r = 0; r < 16; ++r) gv[0][r] = gpb[(size_t)crow(r, hi) * 2048]; }
    asm volatile("s_waitcnt lgkmcnt(0)\n\ts_barrier" ::: "memory");
    LAS3 float* X = (LAS3 float*)shm + rg * 4096;
    if (sub == 1) {
#pragma unroll
      for (int d = 0; d < ND; ++d)
#pragma unroll
        for (int r = 0; r < 16; ++r) X[(d * 16 + r) * 64 + lane] = o[d][r] * rli[r] * lam;
    }
    asm volatile("s_waitcnt lgkmcnt(0)\n\ts_barrier" ::: "memory");
    if (sub == 0 && !dummy) {
      float ss[16];
#pragma unroll
      for (int r = 0; r < 16; ++r) { float s = 0.f;
#pragma unroll
        for (int d = 0; d < ND; ++d) { const float v = o[d][r] * rli[r] - X[(d * 16 + r) * 64 + lane]; o[d][r] = v; s += v * v; }
        s += __shfl_xor(s, 1); s += __shfl_xor(s, 2); s += __shfl_xor(s, 4); s += __shfl_xor(s, 8); s += __shfl_xor(s, 16);
        ss[r] = 0.8f / sqrtf(s * (1.0f / 128.0f) + 1e-6f); }
#pragma unroll
      for (int d = 0; d < ND; ++d) { const float gsub = T.subg[d * 32 + r32];
        if (d + 1 < ND) {
#pragma unroll
          for (int r = 0; r < 16; ++r) gv[(d + 1) & 1][r] = gpb[(size_t)crow(r, hi) * 2048 + (d + 1) * 32]; }
#pragma unroll
        for (int r = 0; r < 16; ++r) { const float g = bf2f(gv[d & 1][r]); const float sg = g / (1.0f + __expf(-g));
          gpb[(size_t)crow(r, hi) * 2048 + d * 32] = f2bf(o[d][r] * ss[r] * gsub * sg); } }
    }
  } else if (!dummy) {
    bf16_t* const gpb = T.G + (size_t)(rowbase + q0w) * 2048 + (hh * 4 + sub) * 64 + r32; bf16_t gv[2][16];
#pragma unroll
    for (int d = 0; d < ND; ++d)
#pragma unroll
      for (int r = 0; r < 16; ++r) gv[d][r] = gpb[(size_t)crow(r, hi) * 2048 + d * 32];
#pragma unroll
    for (int d = 0; d < ND; ++d)
#pragma unroll
      for (int r = 0; r < 16; ++r) { const float g = bf2f(gv[d][r]); const float sg = g / (1.0f + __expf(-g));
        gpb[(size_t)crow(r, hi) * 2048 + d * 32] = f2bf(o[d][r] * rli[r] * sg); }
  }
  if (!MODE && dummy) {
#pragma unroll
    for (int d = 0; d < ND; ++d) asm volatile("" :: "v"(o[d]));
    asm volatile("" :: "v"(rli[0]), "v"(rli[15]));
  }
  ATT_WAIT_BAR(0);
}
}
namespace cg = cooperative_groups;
constexpr int NWAVES = 8;
constexpr int DM = 2048, NPROJ = 6656, MTOK = 65536, MP = 32768;
constexpr size_t MiB = 1u << 20;
constexpr size_t WS_LAM = 0, WS_TAB = 4096;
constexpr size_t WS_WIN = 2 * MiB, WS_WOUT = 28 * MiB, WS_PART = 36 * MiB;
constexpr size_t WS_QA = 64 * MiB, WS_KVA = 192 * MiB, WS_QKVB = 256 * MiB, WS_G = 640 * MiB, WS_END = 896 * MiB;
constexpr int LDS_BYTES = 147456;
#define GAS __attribute__((address_space(1)))
#define LAS __attribute__((address_space(3)))
typedef unsigned short bf16;
typedef unsigned v4u __attribute__((ext_vector_type(4)));
typedef float f32x4 __attribute__((ext_vector_type(4)));
#define LDS_WAIT() asm volatile("s_waitcnt lgkmcnt(0)" ::: "memory")
__device__ __forceinline__ unsigned f2bf_rne(float f) { unsigned u = __builtin_bit_cast(unsigned, f); return (u + 0x7fffu + ((u >> 16) & 1u)) >> 16; }
__device__ __forceinline__ unsigned pk2(float lo, float hi) { return f2bf_rne(lo) | (f2bf_rne(hi) << 16); }
__device__ __forceinline__ float wave_sum(float v) {
#pragma unroll
    for (int o = 1; o < 64; o <<= 1) v += __shfl_xor(v, o);
    return v;
}
__device__ __forceinline__ void p0_transpose_item(const float* W, int K, int N, bf16* WT, LAS float* scr, int item, int lane) {
    const int nblk = N / 32, kb = item / nblk, nb = item % nblk, k0 = 64 * kb, n0 = 32 * nb;
#pragma unroll 8
    for (int i = 0; i < 32; ++i) { const int kk = 2 * i + (lane >> 5); scr[kk * 33 + (lane & 31)] = W[(size_t)(k0 + kk) * N + n0 + (lane & 31)]; }
    LDS_WAIT(); asm volatile("" ::: "memory");
    const int c = lane & 7;
#pragma unroll
    for (int j = 0; j < 4; ++j) { const int n = (lane >> 3) + 8 * j; const LAS float* s = scr + (8 * c) * 33 + n;
        v4u o; o.x = pk2(s[0 * 33], s[1 * 33]); o.y = pk2(s[2 * 33], s[3 * 33]); o.z = pk2(s[4 * 33], s[5 * 33]); o.w = pk2(s[6 * 33], s[7 * 33]);
        *(GAS v4u*)(WT + (size_t)(n0 + n) * K + k0 + 8 * c) = o; }
    LDS_WAIT(); asm volatile("" ::: "memory");
}
__device__ __forceinline__ void rms_row_to_bf16(const float* xrow, const float* g, bf16* orow, int lane) {
    const f32x4* xr = (const f32x4*)xrow + lane; const f32x4* gr = (const f32x4*)g + lane;
    f32x4 v[8]; float s = 0.f;
#pragma unroll
    for (int j = 0; j < 8; ++j) { v[j] = xr[64 * j]; s += (v[j].x * v[j].x + v[j].y * v[j].y) + (v[j].z * v[j].z + v[j].w * v[j].w); }
    const float r = 1.f / sqrtf(wave_sum(s) * (1.f / DM) + 1e-6f);
    unsigned long long* o8 = (unsigned long long*)orow + lane;
#pragma unroll
    for (int j = 0; j < 8; ++j) { const f32x4 gg = gr[64 * j];
        o8[64 * j] = (unsigned long long)pk2(v[j].x * r * gg.x, v[j].y * r * gg.y) | ((unsigned long long)pk2(v[j].z * r * gg.z, v[j].w * r * gg.w) << 32); }
}
__device__ __forceinline__ int t5_bucket(int rel) {
    const int n = rel < 0 ? -rel : rel; int bk = rel > 0 ? 16 : 0;
    if (n < 8) return bk + n;
    const int large = 8 + (n >= 12) + (n >= 16) + (n >= 23) + (n >= 32) + (n >= 46) + (n >= 64) + (n >= 91);
    return bk + large;
}

struct Args { const float* in[13]; float* out; unsigned char* ws; };
__global__ void __launch_bounds__(NWAVES * 64, 2) mixer_fwd(Args args) {
    extern __shared__ __attribute__((aligned(16))) unsigned char lds[];
    cg::grid_group grid = cg::this_grid();
    const int tid = threadIdx.x, lane = tid & 63, wave = __builtin_amdgcn_readfirstlane(tid >> 6);
    const int G = gridDim.x, bx = blockIdx.x; const int vcu = (G % 8 == 0) ? (bx % 8) * (G / 8) + bx / 8 : bx;
    unsigned char* ws = args.ws;
    const float* xp = args.in[0]; const float* xs = args.in[1];
    bf16* Win_t = (bf16*)(ws + WS_WIN); bf16* Wout_t = (bf16*)(ws + WS_WOUT);
    bf16* XN = (bf16*)args.out;
    bf16* QA = (bf16*)(ws + WS_QA); bf16* KVA = (bf16*)(ws + WS_KVA); bf16* QKVB = (bf16*)(ws + WS_QKVB); bf16* GB = (bf16*)(ws + WS_G);
    float* part = (float*)(ws + WS_PART); float* gtab = (float*)(ws + WS_TAB); float* lamp = (float*)(ws + WS_LAM);

    for (int p0pass = 0; p0pass < (ATT_ABL == 6 ? 2 : 1); ++p0pass) {
        LAS float* scr = (LAS float*)((LAS unsigned char*)lds + wave * 16384);
        const int gw = vcu * NWAVES + wave, NGW = G * NWAVES;
        constexpr int I_IN = (DM / 64) * (NPROJ / 32), I_OUT = (DM / 64) * (DM / 32);
        for (int it = gw; it < I_IN + I_OUT; it += NGW) {
            if (it < I_IN) p0_transpose_item(args.in[3], DM, NPROJ, Win_t, scr, it, lane);
            else p0_transpose_item(args.in[4], DM, DM, Wout_t, scr, it - I_IN, lane);
        }
        for (int m = gw; m < MTOK; m += NGW) rms_row_to_bf16(m < MP ? xp + (size_t)m * DM : xs + (size_t)(m - MP) * DM, args.in[2], XN + (size_t)m * DM, lane);
        for (int i = bx * 512 + tid; i < 24 * att::TABW; i += G * 512) { const int h = i / att::TABW, e = i % att::TABW, rel = e - att::TAB0;
            float v = 0.f;
            { v = args.in[11][t5_bucket(rel) * 24 + h] * 1.4426950408889634f; if (h < 16 && (rel < -128 || rel > 128)) v = -1e30f; }
            gtab[i] = v; }
        if (bx == 0 && wave == 0) { const float a = wave_sum(args.in[6][lane] * args.in[7][lane]), c = wave_sum(args.in[8][lane] * args.in[9][lane]);
            if (lane == 0) lamp[0] = expf(a) - expf(c) + 0.2f; }
    }
    grid.sync();
    {
        pg8::Gemm g{XN, Win_t, MTOK, NPROJ, DM}; pg8::StaticOrder S; S.init(MTOK, NPROJ, G, bx);
        pg8::EpiProj E{QA, KVA, QKVB, GB, att::C2};
        pg8::gemm_phase<pg8::EpiProj, pg8::StaticOrder, true, true>((LAS unsigned char*)lds, g, S, E);
    }
    grid.sync();
    {
        const att::Tensors T{QA, KVA, QKVB, GB, gtab, args.in[5], args.in[10], lamp};
        for (int U = vcu; U < 4096; U += G) {
            const int i = U >> 8, v = U & 255, xcd = v >> 5, j = v & 31;
            int ureq, b, hB, qb;
            if (i < 8) { ureq = 0; const int p = xcd * 8 + i; b = p >> 3; hB = p & 7; qb = j; }
            else { ureq = 1; const int ii = i - 8, p = xcd * 4 + (ii >> 1); b = p >> 3; hB = p & 7; qb = (ii & 1) * 32 + j; }
#if ATT_ABL >= 1 && ATT_ABL <= 4
            att::attn_unit<1>(T, ureq, b, hB, qb, (LAS char*)lds, true);
#endif
            att::attn_unit<1>(T, ureq, b, hB, qb, (LAS char*)lds);
        }
        for (int U = vcu; U < 4096; U += G) {
            int u = (U & 255) * 16 + (U >> 8), ureq, b, kvh, qb;
            if (u < 2048) { ureq = 0; b = u >> 8; kvh = (u >> 6) & 3; qb = u & 63; }
            else { u -= 2048; ureq = 1; b = u >> 9; kvh = (u >> 7) & 3; qb = u & 127; }
#if ATT_ABL == 5
            att::attn_unit<0>(T, ureq, b, kvh, qb, (LAS char*)lds, true);
#endif
            att::attn_unit<0>(T, ureq, b, kvh, qb, (LAS char*)lds);
        }
    }
    grid.sync();
    {
        pg8::Gemm g{GB, Wout_t, MTOK, DM, DM}; pg8::StaticOrder S; S.init(MTOK, DM, G, bx);
        pg8::EpiRes E{xp, xs, (bf16*)(ws + WS_QKVB), part};
        pg8::gemm_phase<pg8::EpiRes, pg8::StaticOrder, true, true>((LAS unsigned char*)lds, g, S, E);
    }
    grid.sync();
    {
        const int gw = vcu * NWAVES + wave, NGW = G * NWAVES; const f32x4* fg = (const f32x4*)args.in[12] + 2 * lane;
        const bf16* zb = (const bf16*)(ws + WS_QKVB);
        for (int m = gw; m < MTOK; m += NGW) {
            const float s = wave_sum(lane < 32 ? part[(size_t)m * 32 + lane] : 0.f);
            const float r = 1.f / sqrtf(s * (1.f / DM) + 1e-6f);
            const v4u* zr = (const v4u*)(zb + (size_t)m * DM) + lane; f32x4* orow = (f32x4*)(args.out + (size_t)m * DM) + 2 * lane;
#pragma unroll
            for (int jj = 0; jj < 4; ++jj) { const v4u z = zr[64 * jj]; const f32x4 g0 = fg[128 * jj], g1 = fg[128 * jj + 1];
                const f32x4 a = {__uint_as_float(z.x << 16), __uint_as_float(z.x & 0xffff0000u), __uint_as_float(z.y << 16), __uint_as_float(z.y & 0xffff0000u)};
                const f32x4 b = {__uint_as_float(z.z << 16), __uint_as_float(z.z & 0xffff0000u), __uint_as_float(z.w << 16), __uint_as_float(z.w & 0xffff0000u)};
                orow[128 * jj] = a * r * g0; orow[128 * jj + 1] = b * r * g1; }
        }
    }
}

extern "C" void kernel_launch(void* const* d_in, const int* in_sizes, int n_in, void* d_out, int out_size, void* d_ws, size_t ws_size, hipStream_t stream) {
    static int grid = 0;
    if (grid == 0) {
        if (n_in != 13 || out_size != MTOK * DM || ws_size < WS_END) { fprintf(stderr, "kernel_launch: unexpected shapes (n_in %d out %d ws %zu)\n", n_in, out_size, ws_size); grid = -1; return; }
        int dev = 0, cus = 0, per_cu = 0;
        hipGetDevice(&dev); hipDeviceGetAttribute(&cus, hipDeviceAttributeMultiprocessorCount, dev);
        if (hipFuncSetAttribute((const void*)mixer_fwd, hipFuncAttributeMaxDynamicSharedMemorySize, LDS_BYTES) != hipSuccess) { fprintf(stderr, "kernel_launch: hipFuncSetAttribute failed\n"); grid = -1; return; }
        hipOccupancyMaxActiveBlocksPerMultiprocessor(&per_cu, (const void*)mixer_fwd, NWAVES * 64, LDS_BYTES);
        (void)hipGetLastError();
        if (per_cu < 1) per_cu = 1;
        grid = cus;
        if (grid != 256) fprintf(stderr, "kernel_launch: note: %d CUs (tuned for 256)\n", grid);
    }
    if (grid < 0) return;
    Args a{};
    for (int i = 0; i < 13; ++i) a.in[i] = (const float*)d_in[i];
    a.out = (float*)d_out; a.ws = (unsigned char*)d_ws;
    void* kargs[] = {&a};
    hipError_t e = hipLaunchCooperativeKernel((const void*)mixer_fwd, dim3(grid), dim3(NWAVES * 64), kargs, LDS_BYTES, stream);
    if (e != hipSuccess) fprintf(stderr, "kernel_launch: cooperative launch failed: %s (grid %d)\n", hipGetErrorString(e), grid);
}
```

```cpp
#include <hip/hip_runtime.h>
#include <hip/hip_cooperative_groups.h>
#include <hip/hip_bf16.h>
#include <cstdio>
#include <cstdint>
#include <cmath>
#define ATT_ABL 0
namespace pg8 {
#define PG8_LAS __attribute__((address_space(3)))
typedef unsigned short bf16_t;
typedef short bf16x8 __attribute__((ext_vector_type(8)));
typedef float f32x4 __attribute__((ext_vector_type(4)));
typedef unsigned u32x4 __attribute__((ext_vector_type(4)));
constexpr int BM = 256, BK = 64, HALF = 128, HTB = HALF * BK * 2  , STAGE_BYTES = 8 * HTB, NXCD = 8, WGM = 8;

__host__ __device__ __forceinline__ int lds_byte(int r, int c) { const int st = (r >> 4) * 2 + (c >> 5), rr = r & 15, cc = c & 31, ob = rr * 64 + cc * 2; return st * 1024 + (ob ^ (((ob >> 9) & 1) << 5)); }
__host__ __device__ __forceinline__ void stage_rc(int b, int& R, int& C) { const int st = b / 1024, sb = b % 1024, swz = sb ^ (((sb >> 9) & 1) << 5); R = (st >> 1) * 16 + swz / 64; C = (st & 1) * 32 + (swz % 64) / 2; }
__host__ __device__ __forceinline__ int perm32(int rho) { const int n = rho >> 4, i = rho & 15; return 8 * (i >> 2) + 4 * n + (i & 3); }

struct Unit { int pm, pn; };
struct Gemm { const bf16_t* A; const bf16_t* Bt; int M, N, K; };

struct StaticOrder {
    int nM, nN, nwg, G, c;
    __host__ __device__ void init(int M, int N, int G_, int c_) { nM = M / BM; nN = N / BM; nwg = nM * nN; G = G_; c = c_; }
    __host__ __device__ bool next(int i, Unit& u) const {
        const long L = (long)i * G + c; if (L >= nwg) return false;
        int wgid = (int)L; { const int q = nwg / NXCD, r = nwg % NXCD, xcd = wgid % NXCD, off = wgid / NXCD; wgid = (xcd < r ? xcd * (q + 1) : r * (q + 1) + (xcd - r) * q) + off; }
        const int nig = WGM * nN, gid = wgid / nig, fm = gid * WGM, gsz = (nM - fm) < WGM ? (nM - fm) : WGM;
        u.pm = fm + ((wgid % nig) % gsz); u.pn = (wgid % nig) / gsz; return true;
    }
    __device__ __forceinline__ void a_ready(const Unit&) const {}
    __device__ __forceinline__ void done(const Unit&) const {}
};
__device__ __forceinline__ unsigned cvt_pk_bf16(float lo, float hi) { unsigned r; asm volatile("v_cvt_pk_bf16_f32 %0, %1, %2" : "=v"(r) : "v"(lo), "v"(hi)); return r; }
typedef float f32x2 __attribute__((ext_vector_type(2)));
struct EpiProj {
    static constexpr bool PERM = true, AFTER_DRAIN = false;
    bf16_t *QA, *KVA, *QKVB, *G; float c2;
    __device__ __forceinline__ void operator()(const f32x4 (&acc)[2][2][4][2], const Unit& u, int wr, int wc, int fr, int fq) const {
        const int row0 = u.pm * BM + wr * 64 + fr; const int colt = u.pn * BM;
        bf16_t* base; int ldc, c0; float sc = 1.f;
        if (colt < 1024)      { base = QA;   ldc = 1024; c0 = colt;        sc = c2; }
        else if (colt < 1536) { base = KVA;  ldc = 512;  c0 = colt - 1024; }
        else if (colt < 2560) { base = G;    ldc = 2048; c0 = colt - 1536; }
        else if (colt < 5632) { base = QKVB; ldc = 3072; c0 = colt - 2560; if (colt < 3584) sc = c2; }
        else                  { base = G;    ldc = 2048; c0 = colt - 5632 + 1024; }
        const int col0 = c0 + wc * 32 + 8 * fq;
#pragma unroll
        for (int ai = 0; ai < 2; ++ai)
#pragma unroll
            for (int m = 0; m < 4; ++m) { bf16_t* rowp = base + (size_t)(row0 + ai * HALF + m * 16) * ldc + col0;
#pragma unroll
                for (int bj = 0; bj < 2; ++bj) { f32x4 v0 = acc[ai][bj][m][0] * sc, v1 = acc[ai][bj][m][1] * sc;
                    u32x4 w; w.x = cvt_pk_bf16(v0[0], v0[1]); w.y = cvt_pk_bf16(v0[2], v0[3]); w.z = cvt_pk_bf16(v1[0], v1[1]); w.w = cvt_pk_bf16(v1[2], v1[3]);
                    *(u32x4*)(rowp + bj * HALF) = w; } }
    }
};
struct EpiRes {
    static constexpr bool PERM = true, AFTER_DRAIN = false;
    const float* xp; const float* xs; bf16_t* zb; float* part;
    __device__ __forceinline__ void operator()(const f32x4 (&acc)[2][2][4][2], const Unit& u, int wr, int wc, int fr, int fq) const {
        const int col0 = u.pn * BM + wc * 32 + 8 * fq;
#pragma unroll
        for (int ai = 0; ai < 2; ++ai)
#pragma unroll
            for (int m = 0; m < 4; ++m) { const int row = u.pm * BM + ai * HALF + wr * 64 + m * 16 + fr;
                const float* xr = (row < 32768 ? xp + (size_t)row * 2048 : xs + (size_t)(row - 32768) * 2048) + col0; bf16_t* zrow = zb + (size_t)row * 2048 + col0;
                float s = 0.f;
#pragma unroll
                for (int bj = 0; bj < 2; ++bj) { const f32x4 v0 = *(const f32x4*)(xr + bj * HALF) + acc[ai][bj][m][0], v1 = *(const f32x4*)(xr + bj * HALF + 4) + acc[ai][bj][m][1];
                    s += ((v0[0] * v0[0] + v0[1] * v0[1]) + (v0[2] * v0[2] + v0[3] * v0[3])) + ((v1[0] * v1[0] + v1[1] * v1[1]) + (v1[2] * v1[2] + v1[3] * v1[3]));
                    u32x4 w; w.x = cvt_pk_bf16(v0[0], v0[1]); w.y = cvt_pk_bf16(v0[2], v0[3]); w.z = cvt_pk_bf16(v1[0], v1[1]); w.w = cvt_pk_bf16(v1[2], v1[3]);
                    *(u32x4*)(zrow + bj * HALF) = w; }
                s += __shfl_xor(s, 16); s += __shfl_xor(s, 32);
                if (fq == 0) part[(size_t)row * 32 + u.pn * 4 + wc] = s; }
    }
};
template <class Epi, class Sched, bool ALIGN_EPI = false, bool SP2 = false>
__device__ __forceinline__ void gemm_phase(PG8_LAS unsigned char* lds, const Gemm g, const Sched& S, const Epi& E) {
    int tid_ = threadIdx.x; asm volatile("" : "+v"(tid_));
    const int tid = tid_, wid = __builtin_amdgcn_readfirstlane(tid >> 6), lane = tid & 63, wr = wid >> 2, wc = wid & 3, fr = lane & 15, fq = lane >> 4;
    const int K = g.K, nt = K / BK;
    unsigned voffA[2], voffB[2];
#pragma unroll
    for (int i = 0; i < 2; ++i) { int R, C; stage_rc(tid * 16 + i * 8192, R, C); const int Rb = Epi::PERM ? ((R & ~31) + perm32(R & 31)) : R;
        voffA[i] = (unsigned)(R * K + C) * 2u; voffB[i] = (unsigned)(Rb * K + C) * 2u; }
    const size_t kstep = (size_t)(BK * 2);
    const size_t hstep = (size_t)HALF * K * 2;
    const size_t tstep = 2 * hstep;
    const unsigned ldsw = (unsigned)wid * 1024u;
    const int aoff = lds_byte(wr * 64 + fr, fq * 8), boff = lds_byte(wc * 32 + fr, fq * 8);
#define PG8_SA(b, h) (((b) * 2 + (h)) * HTB)
#define PG8_SB(b, h) ((4 + (b) * 2 + (h)) * HTB)
#define PG8_STAGE(bufoff, gbase, voff) do { _Pragma("unroll") for (int _i = 0; _i < 2; ++_i) \
        __builtin_amdgcn_global_load_lds((const unsigned*)((const char*)(gbase) + (voff)[_i]), (PG8_LAS unsigned*)(lds + (bufoff) + ldsw + _i * 8192), 16, 0, 0); } while (0)
#define PG8_LDA(dst, b, h) do { _Pragma("unroll") for (int m = 0; m < 4; ++m) _Pragma("unroll") for (int k = 0; k < 2; ++k) dst[m][k] = *(const PG8_LAS bf16x8*)(lds + PG8_SA(b, h) + aoff + m * 2048 + k * 1024); } while (0)
#define PG8_LDB(dst, b, h) do { _Pragma("unroll") for (int n = 0; n < 2; ++n) _Pragma("unroll") for (int k = 0; k < 2; ++k) dst[n][k] = *(const PG8_LAS bf16x8*)(lds + PG8_SB(b, h) + boff + n * 2048 + k * 1024); } while (0)
#define PG8_MMA(ai, bj, At, Bt) do { __builtin_amdgcn_s_setprio(1); _Pragma("unroll") for (int m = 0; m < 4; ++m) _Pragma("unroll") for (int n = 0; n < 2; ++n) _Pragma("unroll") for (int k = 0; k < 2; ++k) \
        acc[ai][bj][m][n] = __builtin_amdgcn_mfma_f32_16x16x32_bf16(Bt[n][k], At[m][k], acc[ai][bj][m][n], 0, 0, 0); __builtin_amdgcn_s_setprio(0); } while (0)
#define PG8_WAIT_V(n) asm volatile("s_waitcnt vmcnt(" #n ")" ::: "memory")
#define PG8_WAIT_L(n) asm volatile("s_waitcnt lgkmcnt(" #n ")" ::: "memory")
#define PG8_BAR __builtin_amdgcn_s_barrier()
#define PG8_SCHED __builtin_amdgcn_sched_barrier(0)
    Unit cur, nxt; int ui = 0;
    if (!S.next(0, cur)) return;
    f32x4 acc[2][2][4][2];
#pragma unroll
    for (int a = 0; a < 2; ++a)
#pragma unroll
        for (int b = 0; b < 2; ++b)
#pragma unroll
            for (int m = 0; m < 4; ++m)
#pragma unroll
                for (int n = 0; n < 2; ++n) acc[a][b][m][n] = (f32x4){0.f, 0.f, 0.f, 0.f};
    bf16x8 At[4][2], B0[2][2], B1[2][2];
    const char* cA = (const char*)g.A + (size_t)cur.pm * tstep; const char* cB = (const char*)g.Bt + (size_t)cur.pn * tstep;
    S.a_ready(cur);
    if constexpr (SP2) {
        PG8_STAGE(PG8_SB(0, 0), cB, voffB); PG8_STAGE(PG8_SB(0, 1), cB + hstep, voffB); PG8_STAGE(PG8_SA(0, 0), cA, voffA); PG8_STAGE(PG8_SA(0, 1), cA + hstep, voffA);
        if (wr == 1) PG8_BAR;
        PG8_WAIT_V(2); PG8_BAR;
        PG8_STAGE(PG8_SB(1, 0), cB + kstep, voffB); PG8_STAGE(PG8_SA(1, 0), cA + kstep, voffA); PG8_STAGE(PG8_SB(1, 1), cB + hstep + kstep, voffB);
        PG8_WAIT_V(6); PG8_BAR;
    } else {
        PG8_STAGE(PG8_SB(0, 0), cB, voffB); PG8_STAGE(PG8_SA(0, 0), cA, voffA); PG8_STAGE(PG8_SB(0, 1), cB + hstep, voffB); PG8_STAGE(PG8_SA(0, 1), cA + hstep, voffA);
        if (wr == 1) PG8_BAR;
        PG8_WAIT_V(4); PG8_BAR;
        PG8_STAGE(PG8_SB(1, 0), cB + kstep, voffB); PG8_STAGE(PG8_SA(1, 0), cA + kstep, voffA); PG8_STAGE(PG8_SB(1, 1), cB + hstep + kstep, voffB);
        PG8_WAIT_V(6); PG8_BAR;
    }
    for (;;) {
        const bool has_next = S.next(ui + 1, nxt);
        const char* nA = has_next ? (const char*)g.A + (size_t)nxt.pm * tstep : cA; const char* nB = has_next ? (const char*)g.Bt + (size_t)nxt.pn * tstep : cB;
        for (int t = 0; t < nt; t += 2) {
            const bool last = (t == nt - 2);
            const char* a1 = cA + (size_t)(t + 1) * kstep;
            const char* a2 = last ? nA : cA + (size_t)(t + 2) * kstep; const char* b2 = last ? nB : cB + (size_t)(t + 2) * kstep;
            const char* a3 = a2 + kstep; const char* b3 = b2 + kstep;
            if (last && has_next) S.a_ready(nxt);
            if constexpr (SP2) {
            PG8_LDB(B0, 0, 0); PG8_LDB(B1, 0, 1); PG8_SCHED; PG8_LDA(At, 0, 0); PG8_STAGE(PG8_SA(1, 1), a1 + hstep, voffA);
            PG8_WAIT_V(8); PG8_WAIT_L(0); PG8_BAR; PG8_MMA(0, 0, At, B0); PG8_MMA(0, 1, At, B1); PG8_BAR; PG8_SCHED;
            PG8_LDA(At, 0, 1); PG8_STAGE(PG8_SB(0, 0), b2, voffB); PG8_STAGE(PG8_SB(0, 1), b2 + hstep, voffB); PG8_STAGE(PG8_SA(0, 0), a2, voffA);
            PG8_WAIT_V(8); PG8_WAIT_L(0); PG8_BAR; PG8_MMA(1, 0, At, B0); PG8_MMA(1, 1, At, B1); PG8_BAR; PG8_SCHED;
            PG8_LDB(B0, 1, 0); PG8_LDB(B1, 1, 1); PG8_SCHED; PG8_LDA(At, 1, 0); PG8_STAGE(PG8_SA(0, 1), a2 + hstep, voffA);
            PG8_WAIT_V(8); PG8_WAIT_L(0); PG8_BAR; PG8_MMA(0, 0, At, B0); PG8_MMA(0, 1, At, B1); PG8_BAR; PG8_SCHED;
            PG8_LDA(At, 1, 1); PG8_STAGE(PG8_SB(1, 0), b3, voffB); PG8_STAGE(PG8_SB(1, 1), b3 + hstep, voffB); PG8_STAGE(PG8_SA(1, 0), a3, voffA);
            PG8_WAIT_V(8); PG8_WAIT_L(0); PG8_BAR; PG8_MMA(1, 0, At, B0); PG8_MMA(1, 1, At, B1); PG8_BAR; PG8_SCHED;
            } else {
            PG8_LDB(B0, 0, 0); PG8_SCHED; PG8_LDA(At, 0, 0); PG8_STAGE(PG8_SA(1, 1), a1 + hstep, voffA);
            PG8_WAIT_L(8); PG8_BAR; PG8_WAIT_L(0); PG8_MMA(0, 0, At, B0); PG8_BAR; PG8_SCHED;
            PG8_LDB(B1, 0, 1); PG8_STAGE(PG8_SB(0, 0), b2, voffB);
            PG8_BAR; PG8_WAIT_L(0); PG8_MMA(0, 1, At, B1); PG8_BAR;
            PG8_LDA(At, 0, 1); PG8_STAGE(PG8_SA(0, 0), a2, voffA);
            PG8_BAR; PG8_WAIT_L(0); PG8_MMA(1, 0, At, B0); PG8_BAR; PG8_SCHED;
            PG8_STAGE(PG8_SB(0, 1), b2 + hstep, voffB);
            PG8_WAIT_V(6); PG8_BAR; PG8_MMA(1, 1, At, B1); PG8_BAR;
            PG8_LDB(B0, 1, 0); PG8_SCHED; PG8_LDA(At, 1, 0); PG8_STAGE(PG8_SA(0, 1), a2 + hstep, voffA);
            PG8_WAIT_L(8); PG8_BAR; PG8_WAIT_L(0); PG8_MMA(0, 0, At, B0); PG8_BAR; PG8_SCHED;
            PG8_LDB(B1, 1, 1); PG8_STAGE(PG8_SB(1, 0), b3, voffB);
            PG8_BAR; PG8_WAIT_L(0); PG8_MMA(0, 1, At, B1); PG8_BAR;
            PG8_LDA(At, 1, 1); PG8_STAGE(PG8_SA(1, 0), a3, voffA);
            PG8_BAR; PG8_WAIT_L(0); PG8_MMA(1, 0, At, B0); PG8_BAR; PG8_SCHED;
            PG8_STAGE(PG8_SB(1, 1), b3 + hstep, voffB);
            PG8_WAIT_V(6); PG8_BAR; PG8_MMA(1, 1, At, B1); PG8_BAR;
            }
        }
        if constexpr (ALIGN_EPI) { if (wr == 0) PG8_BAR; }
        if constexpr (!Epi::AFTER_DRAIN) { E(acc, cur, wr, wc, fr, fq); S.done(cur); }
        if (!has_next) break;
#pragma unroll
        for (int a = 0; a < 2; ++a)
#pragma unroll
            for (int b = 0; b < 2; ++b)
#pragma unroll
                for (int m = 0; m < 4; ++m)
#pragma unroll
                    for (int n = 0; n < 2; ++n) acc[a][b][m][n] = (f32x4){0.f, 0.f, 0.f, 0.f};
        cur = nxt; cA = nA; cB = nB; ++ui;
        if constexpr (ALIGN_EPI) { if (wr == 1) PG8_BAR; }
    }
    PG8_WAIT_V(0);
    if constexpr (!ALIGN_EPI) { if (wr == 0) PG8_BAR; }
    PG8_BAR;
    if constexpr (Epi::AFTER_DRAIN) { E.fused(acc, cur, wr, wc, fr, fq, lds, wid, lane); S.done(cur); }
#undef PG8_SA
#undef PG8_SB
#undef PG8_STAGE
#undef PG8_LDA
#undef PG8_LDB
#undef PG8_MMA
#undef PG8_WAIT_V
#undef PG8_WAIT_L
#undef PG8_BAR
#undef PG8_SCHED
}
}
namespace att {
#define LAS3 __attribute__((address_space(3)))
typedef LAS3 const char* lds_cptr;
typedef unsigned short bf16_t;
using bf16x8 = __attribute__((ext_vector_type(8))) short;
using s16x4 = __attribute__((ext_vector_type(4))) short;
using f32x16 = __attribute__((ext_vector_type(16))) float;
using u32x4 = __attribute__((ext_vector_type(4))) unsigned;
typedef short v4i16_t __attribute__((ext_vector_type(4)));
constexpr int SLOTB = 32768, NSLOT = 4, OFF_K2 = 8192, OFF_V = 16384;
constexpr int LDS_WS = NSLOT * SLOTB;
constexpr int LDS_TAB = LDS_WS + 2048;
constexpr int LDS_END = LDS_TAB + 9216;
constexpr int TABW = 576, TAB0 = 288;
constexpr float LOG2E = 1.4426950408889634f;
constexpr float C2 = 0.125f * LOG2E;
constexpr float THRL = 8.0f;
__device__ __forceinline__ int crow(int r, int hi) { return (r & 3) + 8 * (r >> 2) + 4 * hi; }
__device__ __forceinline__ void glds16(const void* gsrc, unsigned lds_dst) { unsigned keep;
  asm volatile("s_mov_b32 %0, m0\n\ts_mov_b32 m0, %2\n\ts_nop 0\n\tglobal_load_lds_dwordx4 %1, off\n\ts_mov_b32 m0, %0" : "=&s"(keep) : "v"(gsrc), "s"(lds_dst) : "memory"); }
typedef float f32x2_t __attribute__((ext_vector_type(2))); typedef __bf16 bf16x2_t __attribute__((ext_vector_type(2)));
__device__ __forceinline__ unsigned cvtpk(float lo, float hi) { f32x2_t v = {lo, hi}; bf16x2_t b = __builtin_convertvector(v, bf16x2_t); return __builtin_bit_cast(unsigned, b); }
__device__ __forceinline__ float bf2f(bf16_t v) { return __uint_as_float((unsigned)v << 16); }
__device__ __forceinline__ bf16_t f2bf(float f) { return (bf16_t)(cvtpk(f, 0.f) & 0xffffu); }
__device__ __forceinline__ float max2f(float a, float b) { float r; asm("v_max_f32_e32 %0, %1, %2" : "=v"(r) : "v"(a), "v"(b)); return r; }
__device__ __forceinline__ float max3f(float a, float b, float c) { float r; asm("v_max3_f32 %0, %1, %2, %3" : "=v"(r) : "v"(a), "v"(b), "v"(c)); return r; }
#define ATT_WAIT_BAR(N) asm volatile("s_waitcnt vmcnt(" #N ") lgkmcnt(0)\n\ts_barrier" ::: "memory")
__device__ __forceinline__ s16x4 vtr(lds_cptr p) { return __builtin_bit_cast(s16x4, __builtin_amdgcn_ds_read_tr16_b64_v4i16((LAS3 v4i16_t*)p)); }

struct Tensors { bf16_t* QA; bf16_t* KVA; bf16_t* QKVB; bf16_t* G; const float* gtab; const float* sink; const float* subg; const float* lamp; };

template <int MODE>
__device__ __forceinline__ void attn_unit(const Tensors& T0, int ureq, int b, int hh, int qblk, LAS3 char* shm, const bool dummy = false) {
  constexpr int ND = MODE ? 4 : 2;
  constexpr int QROWS = MODE ? 128 : 64;
  constexpr int PQ = MODE ? 3072 : 1024, PK = MODE ? 3072 : 512;
  int tid = threadIdx.x; asm volatile("" : "+v"(tid));
  Tensors T = T0;
  asm volatile("" : "+s"(T.QA), "+s"(T.KVA), "+s"(T.QKVB), "+s"(T.G)); asm volatile("" : "+s"(T.gtab), "+s"(T.sink), "+s"(T.subg), "+s"(T.lamp));
  const int lane = tid & 63, r32 = lane & 31, hi = lane >> 5; const int wid = __builtin_amdgcn_readfirstlane(tid >> 6);
  const int S = ureq ? 8192 : 4096;
  const long rowbase = ureq ? 32768 + (long)b * 8192 : (long)b * 4096;
  const int rg = MODE ? (wid & 3) : (wid & 1);
  const int sub = MODE ? (wid >> 2) : (wid >> 1);
  const int Q0 = qblk * QROWS, q0w = Q0 + rg * 32;
  const bf16_t* Qw = MODE ? T.QKVB + (rowbase + q0w) * PQ + hh * 128 + sub * 64 : T.QA + (rowbase + q0w) * PQ + (hh * 4 + sub) * 64;
  const bf16_t* Kh = MODE ? T.QKVB + rowbase * PK + 1024 + hh * 128 : T.KVA + rowbase * PK + hh * 64;
  const bf16_t* Vh = MODE ? T.QKVB + rowbase * PK + 2048 + hh * 128 : T.KVA + rowbase * PK + 256 + hh * 64;
  const unsigned lds0 = (unsigned)(uintptr_t)shm;
  LAS3 float* wsf = (LAS3 float*)(shm + LDS_WS) + wid * 64;
  LAS3 float* tab = (LAS3 float*)(shm + LDS_TAB);
  { const float* gt = T.gtab + (MODE ? (16 + hh) : hh * 4) * TABW; for (int i = tid; i < (MODE ? 1 : 4) * TABW; i += 512) tab[i] = gt[i]; }
  float cbL = 0.f, cbR = 0.f, lam = 0.f, sinkv = 0.f;
  if (MODE) { cbL = T.gtab[(16 + hh) * TABW]; cbR = T.gtab[(16 + hh) * TABW + TABW - 1]; lam = T.lamp[0]; } else { sinkv = T.sink[hh * 4 + sub] * LOG2E; }
  bf16x8 qr[4];
#pragma unroll
  for (int d0 = 0; d0 < 4; ++d0) qr[d0] = *reinterpret_cast<const bf16x8*>(&Qw[(long)r32 * PQ + d0 * 16 + hi * 8]);
  asm volatile("s_waitcnt vmcnt(0)" ::: "memory");
  const int drow = 8 * wid + (lane >> 3);
  const bf16_t* ksrc = Kh + (long)drow * PK + (((lane & 7) ^ ((drow >> 1) & 7)) * 8);
  const bf16_t* vsrc = Vh + (long)drow * PK + ((((lane >> 2) & 1) ^ ((lane >> 4) & 1)) * 32) + (lane & 3) * 8;
  const unsigned dwv = lds0 + wid * 1024;
#define ATT_DMA(t, so) do { const long _o = (long)(t) * 64 * PK; \
    glds16(ksrc + _o, (unsigned)__builtin_amdgcn_readfirstlane(dwv + (so))); \
    if (MODE) glds16(ksrc + 64 + _o, (unsigned)__builtin_amdgcn_readfirstlane(dwv + (so) + OFF_K2)); \
    glds16(vsrc + _o, (unsigned)__builtin_amdgcn_readfirstlane(dwv + (so) + OFF_V)); \
    if (MODE) glds16(vsrc + 64 + _o, (unsigned)__builtin_amdgcn_readfirstlane(dwv + (so) + OFF_V + 8192)); } while (0)
  int t_lo = 0, t_hi = S / 64;
  if (!MODE) { t_lo = (Q0 >= 128 ? Q0 - 128 : 0) / 64; const int e = Q0 + 64 + 128; t_hi = (e < S ? e : S) / 64; }
  const int NT = t_hi - t_lo;
  const int grp = wid >> 2;
  lds_cptr kp[4];
#pragma unroll
  for (int d0 = 0; d0 < 4; ++d0) kp[d0] = (lds_cptr)shm + (MODE ? sub * OFF_K2 : 0) + r32 * 128 + (((2 * d0 + hi) ^ ((r32 >> 1) & 7)) << 4);
  const int vrow = 4 * hi + ((lane & 15) >> 2), vsw = (lane >> 3) & 1;
  const lds_cptr vpe = (lds_cptr)shm + OFF_V + vrow * 128 + vsw * 64 + ((lane >> 4) & 1) * 32 + (lane & 3) * 8;
  const lds_cptr vpo = (lds_cptr)shm + OFF_V + vrow * 128 + (vsw ^ 1) * 64 + ((lane >> 4) & 1) * 32 + (lane & 3) * 8;
  float mhat, l_reg, curcb; bool first; f32x16 o[ND]; f32x16 negm; u32x4 pw[4];
#define ATT_BAR_V(full) do { if (full) { if (MODE) ATT_WAIT_BAR(4); else ATT_WAIT_BAR(2); } else ATT_WAIT_BAR(0); } while (0)
#define ATT_BAR_L() asm volatile("s_waitcnt lgkmcnt(0)\n\ts_barrier" ::: "memory")
#define ATT_SB() __builtin_amdgcn_sched_barrier(0)
#define ATT_VREAD(buf, ks, vso) do { _Pragma("unroll") for (int d0 = 0; d0 < ND; ++d0) { const lds_cptr vq_ = ((d0 & 1) ? vpo : vpe) + (vso) + (d0 >> 1) * 8192 + (ks) * 2048; \
      const s16x4 lo = vtr(vq_), hi4 = vtr(vq_ + 1024); \
      buf[d0] = (bf16x8){lo[0], lo[1], lo[2], lo[3], hi4[0], hi4[1], hi4[2], hi4[3]}; } } while (0)
#define ATT_PVK(buf, ks) do { _Pragma("unroll") for (int d0 = 0; d0 < ND; ++d0) \
      o[d0] = __builtin_amdgcn_mfma_f32_32x32x16_bf16(__builtin_bit_cast(bf16x8, pw[ks]), buf[d0], o[d0], 0, 0, 0); } while (0)
#define ATT_VREAD1(buf, d0, ks, vso) do { const lds_cptr vq_ = (((d0) & 1) ? vpo : vpe) + (vso) + ((d0) >> 1) * 8192 + (ks) * 2048; \
      const s16x4 lo = vtr(vq_), hi4 = vtr(vq_ + 1024); buf[d0] = (bf16x8){lo[0], lo[1], lo[2], lo[3], hi4[0], hi4[1], hi4[2], hi4[3]}; } while (0)
#define ATT_PVK_RD(buf, ks, vp) do { _Pragma("unroll") for (int d0 = 0; d0 < ND; ++d0) { \
      o[d0] = __builtin_amdgcn_mfma_f32_32x32x16_bf16(__builtin_bit_cast(bf16x8, pw[ks]), buf[d0], o[d0], 0, 0, 0); ATT_VREAD1(buf, d0, (ks) + 2, vp); ATT_SB(); } } while (0)
#define ATT_PV_REST(vp) do { ATT_PVK_RD(vA, 0, vp); ATT_PVK_RD(vB, 1, vp); ATT_PVK(vA, 2); ATT_PVK(vB, 3); } while (0)
  bf16x8 vA[ND], vB[ND];
  mhat = MODE ? 0.f : sinkv; l_reg = (!MODE && hi == 0) ? 1.f : 0.f; curcb = 0.f; first = MODE ? true : false;
#pragma unroll
  for (int d = 0; d < ND; ++d) o[d] = f32x16{};
#pragma unroll
  for (int r = 0; r < 16; ++r) negm[r] = -mhat;
#pragma unroll
  for (int j = 0; j < 4; ++j) pw[j] = (u32x4){0u, 0u, 0u, 0u};
  if (!(ATT_ABL == 2 && dummy)) { ATT_DMA(t_lo, 0); ATT_DMA(t_lo + 1, SLOTB); }
  ATT_BAR_V(true);
  if (grp == 1) { if (NT > 2 && !(ATT_ABL == 2 && dummy)) ATT_DMA(t_lo + 2, 2 * SLOTB); ATT_BAR_L(); }
  for (int i = 0; i < NT; ++i) {
    const int t = t_lo + i;
    const int k0 = t * 64;
    float cb = 0.f; bool near = true;
    if (MODE) { if (k0 + 63 - Q0 <= -91) { cb = cbL; near = false; } else if (k0 - (Q0 + 127) >= 91) { cb = cbR; near = false; } }
    if (cb != curcb) { curcb = cb;
#pragma unroll
      for (int r = 0; r < 16; ++r) negm[r] = cb - mhat; }
    f32x16 C0 = negm, C1 = negm;
    if (!(ATT_ABL == 4 && dummy)) { const int kso = (i & 3) * SLOTB; const int vp = ((i - 1) & 3) * SLOTB;
      bf16x8 kf[8];
#pragma unroll
      for (int d0 = 0; d0 < 2; ++d0) { kf[2 * d0] = *(const LAS3 bf16x8*)(kp[d0] + kso); kf[2 * d0 + 1] = *(const LAS3 bf16x8*)(kp[d0] + kso + 4096); }
      if (i > 0) { ATT_VREAD(vB, 1, vp); }
      ATT_SB();
      if (i > 0) { ATT_PVK_RD(vA, 0, vp); }
      C0 = __builtin_amdgcn_mfma_f32_32x32x16_bf16(kf[0], qr[0], negm, 0, 0, 0); C1 = __builtin_amdgcn_mfma_f32_32x32x16_bf16(kf[1], qr[0], negm, 0, 0, 0);
      C0 = __builtin_amdgcn_mfma_f32_32x32x16_bf16(kf[2], qr[1], C0, 0, 0, 0); C1 = __builtin_amdgcn_mfma_f32_32x32x16_bf16(kf[3], qr[1], C1, 0, 0, 0);
      ATT_SB();
#pragma unroll
      for (int d0 = 2; d0 < 4; ++d0) { kf[2 * d0] = *(const LAS3 bf16x8*)(kp[d0] + kso); kf[2 * d0 + 1] = *(const LAS3 bf16x8*)(kp[d0] + kso + 4096); }
      ATT_SB();
      if (i > 0) { ATT_PVK_RD(vB, 1, vp); }
#pragma unroll
      for (int d0 = 2; d0 < 4; ++d0) { C0 = __builtin_amdgcn_mfma_f32_32x32x16_bf16(kf[2 * d0], qr[d0], C0, 0, 0, 0); C1 = __builtin_amdgcn_mfma_f32_32x32x16_bf16(kf[2 * d0 + 1], qr[d0], C1, 0, 0, 0); }
      ATT_SB();
      if (i > 0) { ATT_PVK(vA, 2); ATT_PVK(vB, 3); } }
    asm volatile("" : "+v"(C0), "+v"(C1));
#pragma unroll
    for (int d = 0; d < ND; ++d) asm volatile("" : "+v"(o[d]));
    if (grp == 0) ATT_BAR_L(); else ATT_BAR_V(i + 2 < NT);
    if (i == 0) asm volatile("s_nop 15\n\ts_nop 7" : "+v"(C0), "+v"(C1));
    else asm volatile("" : "+v"(C0), "+v"(C1));
    ATT_VREAD(vA, 0, (i & 3) * SLOTB); ATT_SB();
    if (grp == 0 && i + 2 < NT && !(ATT_ABL == 2 && dummy)) ATT_DMA(t + 2, ((i + 2) & 3) * SLOTB);
    if (grp == 1 && i + 3 < NT && !(ATT_ABL == 2 && dummy)) ATT_DMA(t + 3, ((i + 3) & 3) * SLOTB);
    if (!(ATT_ABL == 3 && dummy)) {
    if (near) {
      const LAS3 float* tp = tab + (MODE ? 0 : sub * TABW) + (k0 - q0w - r32 + 4 * hi + TAB0);
#pragma unroll
      for (int r = 0; r < 16; ++r) { C0[r] += tp[(r & 3) + 8 * (r >> 2)]; C1[r] += tp[(r & 3) + 8 * (r >> 2) + 32]; }
    }
    float rm;
    { float a = max3f(C0[0], C0[1], C1[0]), bq = max3f(C0[2], C0[3], C1[1]); a = max3f(a, C1[2], C1[3]);
#pragma unroll
      for (int r = 4; r < 16; r += 4) { a = max3f(a, C0[r], C0[r + 1]); bq = max3f(bq, C0[r + 2], C0[r + 3]); a = max3f(a, C1[r], C1[r + 1]); bq = max3f(bq, C1[r + 2], C1[r + 3]); }
      a = max2f(a, bq);
      auto rr = __builtin_amdgcn_permlane32_swap(__float_as_uint(a), __float_as_uint(a), false, false);
      rm = max2f(__uint_as_float(rr[0]), __uint_as_float(rr[1])); }
    if (first || __any(rm > THRL)) {
      const float dl = first ? rm : __builtin_fmaxf(rm, 0.f);
      mhat += dl;
#pragma unroll
      for (int r = 0; r < 16; ++r) { C0[r] -= dl; C1[r] -= dl; negm[r] = curcb - mhat; }
      if (!first) {
        const float f = __builtin_amdgcn_exp2f(-dl); l_reg *= f;
        if (hi == 0) wsf[r32] = f;
        asm volatile("s_waitcnt lgkmcnt(0)" ::: "memory");
#pragma unroll
        for (int r = 0; r < 16; ++r) { const float fr_ = wsf[crow(r, hi)];
#pragma unroll
          for (int d = 0; d < ND; ++d) o[d][r] *= fr_; }
      }
      first = false;
    }
    float sacc = 0.f;
#pragma unroll
    for (int r = 0; r < 16; ++r) { C0[r] = __builtin_amdgcn_exp2f(C0[r]); C1[r] = __builtin_amdgcn_exp2f(C1[r]); sacc += C0[r] + C1[r]; }
    l_reg += sacc;
#pragma unroll
    for (int j = 0; j < 4; ++j) { pw[0][j] = cvtpk(C0[2 * j], C0[2 * j + 1]); pw[1][j] = cvtpk(C0[8 + 2 * j], C0[8 + 2 * j + 1]);
                                  pw[2][j] = cvtpk(C1[2 * j], C1[2 * j + 1]); pw[3][j] = cvtpk(C1[8 + 2 * j], C1[8 + 2 * j + 1]); }
    }
    asm volatile("" : "+v"(pw[0]), "+v"(pw[1]), "+v"(pw[2]), "+v"(pw[3]), "+v"(l_reg));
    if (grp == 0) ATT_BAR_V(i + 2 < NT); else if (i + 1 < NT) ATT_BAR_L();
  }
  { const int vp = ((NT - 1) & 3) * SLOTB; ATT_VREAD(vB, 1, vp); ATT_SB(); ATT_PV_REST(vp); }
#undef ATT_VREAD
#undef ATT_PVK
#undef ATT_PV_REST
#undef ATT_VREAD1
#undef ATT_PVK_RD
#undef ATT_SB
#undef ATT_BAR_V
#undef ATT_BAR_L
#undef ATT_DMA
  { auto rr = __builtin_amdgcn_permlane32_swap(__float_as_uint(l_reg), __float_as_uint(l_reg), false, false); l_reg = __uint_as_float(rr[0]) + __uint_as_float(rr[1]); }
  if (hi == 0) wsf[32 + r32] = l_reg;
  asm volatile("s_waitcnt lgkmcnt(0)" ::: "memory");
  float rli[16];
#pragma unroll
  for (int r = 0; r < 16; ++r) rli[r] = 1.0f / wsf[32 + crow(r, hi)];
  if (MODE) {
    bf16_t* const gpb = T.G + (size_t)(rowbase + q0w) * 2048 + 1024 + hh * 128 + r32;
    bf16_t gv[2][16];
    if (sub == 0 && !dummy) {
#pragma unroll
      for (int r = 0; r < 16; ++r) gv[0][r] = gpb[(size_t)crow(r, hi) * 2048]; }
    asm volatile("s_waitcnt lgkmcnt(0)\n\ts_barrier" ::: "memory");
    LAS3 float* X = (LAS3 float*)shm + rg * 4096;
    if (sub == 1) {
#pragma unroll
      for (int d = 0; d < ND; ++d)
#pragma unroll
        for (int r = 0; r < 16; ++r) X[(d * 16 + r) * 64 + lane] = o[d][r] * rli[r] * lam;
    }
    asm volatile("s_waitcnt lgkmcnt(0)\n\ts_barrier" ::: "memory");
    if (sub == 0 && !dummy) {
      float ss[16];
#pragma unroll
      for (int r = 0; r < 16; ++r) { float s = 0.f;
#pragma unroll
        for (int d = 0; d < ND; ++d) { const float v = o[d][r] * rli[r] - X[(d * 16 + r) * 64 + lane]; o[d][r] = v; s += v * v; }
        s += __shfl_xor(s, 1); s += __shfl_xor(s, 2); s += __shfl_xor(s, 4); s += __shfl_xor(s, 8); s += __shfl_xor(s, 16);
        ss[r] = 0.8f / sqrtf(s * (1.0f / 128.0f) + 1e-6f); }
#pragma unroll
      for (int d = 0; d < ND; ++d) { const float gsub = T.subg[d * 32 + r32];
        if (d + 1 < ND) {
#pragma unroll
          for (int r = 0; r < 16; ++r) gv[(d + 1) & 1][r] = gpb[(size_t)crow(r, hi) * 2048 + (d + 1) * 32]; }
#pragma unroll
        for (int r = 0; r < 16; ++r) { const float g = bf2f(gv[d & 1][r]); const float sg = g / (1.0f + __expf(-g));
          gpb[(size_t)crow(r, hi) * 2048 + d * 32] = f2bf(o[d][r] * ss[r] * gsub * sg); } }
    }
  } else if (!dummy) {
    bf16_t* const gpb = T.G + (size_t)(rowbase + q0w) * 2048 + (hh * 4 + sub) * 64 + r32; bf16_t gv[2][16];
#pragma unroll
    for (int d = 0; d < ND; ++d)
#pragma unroll
      for (int r = 0; r < 16; ++r) gv[d][r] = gpb[(size_t)crow(r, hi) * 2048 + d * 32];
#pragma unroll
    for (int d = 0; d < ND; ++d)
#pragma unroll
      for (int r = 0; r < 16; ++r) { const float g = bf2f(gv[d][r]); const float sg = g / (1.0f + __expf(-g));
        gpb[(size_t)crow(r, hi) * 2048 + d * 32] = f2bf(o[d][r] * rli[r] * sg); }
  }
  if (!MODE && dummy) {
#pragma unroll
    for (int d = 0; d < ND; ++d) asm volatile("" :: "v"(o[d]));
    asm volatile("" :: "v"(rli[0]), "v"(rli[15]));
  }
  ATT_WAIT_BAR(0);
}
}
namespace cg = cooperative_groups;
constexpr int NWAVES = 8;
constexpr int DM = 2048, NPROJ = 6656, MTOK = 65536, MP = 32768;
constexpr size_t MiB = 1u << 20;
constexpr size_t WS_LAM = 0, WS_TAB = 4096;
constexpr size_t WS_WIN = 2 * MiB, WS_WOUT = 28 * MiB, WS_PART = 36 * MiB;
constexpr size_t WS_QA = 64 * MiB, WS_KVA = 192 * MiB, WS_QKVB = 256 * MiB, WS_G = 640 * MiB, WS_END = 896 * MiB;
constexpr int LDS_BYTES = 147456;
#define GAS __attribute__((address_space(1)))
#define LAS __attribute__((address_space(3)))
typedef unsigned short bf16;
typedef unsigned v4u __attribute__((ext_vector_type(4)));
typedef float f32x4 __attribute__((ext_vector_type(4)));
#define LDS_WAIT() asm volatile("s_waitcnt lgkmcnt(0)" ::: "memory")
__device__ __forceinline__ unsigned f2bf_rne(float f) { unsigned u = __builtin_bit_cast(unsigned, f); return (u + 0x7fffu + ((u >> 16) & 1u)) >> 16; }
__device__ __forceinline__ unsigned pk2(float lo, float hi) { return f2bf_rne(lo) | (f2bf_rne(hi) << 16); }
__device__ __forceinline__ float wave_sum(float v) {
#pragma unroll
    for (int o = 1; o < 64; o <<= 1) v += __shfl_xor(v, o);
    return v;
}
__device__ __forceinline__ void p0_transpose_item(const float* W, int K, int N, bf16* WT, LAS float* scr, int item, int lane) {
    const int nblk = N / 32, kb = item / nblk, nb = item % nblk, k0 = 64 * kb, n0 = 32 * nb;
#pragma unroll 8
    for (int i = 0; i < 32; ++i) { const int kk = 2 * i + (lane >> 5); scr[kk * 33 + (lane & 31)] = W[(size_t)(k0 + kk) * N + n0 + (lane & 31)]; }
    LDS_WAIT(); asm volatile("" ::: "memory");
    const int c = lane & 7;
#pragma unroll
    for (int j = 0; j < 4; ++j) { const int n = (lane >> 3) + 8 * j; const LAS float* s = scr + (8 * c) * 33 + n;
        v4u o; o.x = pk2(s[0 * 33], s[1 * 33]); o.y = pk2(s[2 * 33], s[3 * 33]); o.z = pk2(s[4 * 33], s[5 * 33]); o.w = pk2(s[6 * 33], s[7 * 33]);
        *(GAS v4u*)(WT + (size_t)(n0 + n) * K + k0 + 8 * c) = o; }
    LDS_WAIT(); asm volatile("" ::: "memory");
}
__device__ __forceinline__ void rms_row_to_bf16(const float* xrow, const float* g, bf16* orow, int lane) {
    const f32x4* xr = (const f32x4*)xrow + lane; const f32x4* gr = (const f32x4*)g + lane;
    f32x4 v[8]; float s = 0.f;
#pragma unroll
    for (int j = 0; j < 8; ++j) { v[j] = xr[64 * j]; s += (v[j].x * v[j].x + v[j].y * v[j].y) + (v[j].z * v[j].z + v[j].w * v[j].w); }
    const float r = 1.f / sqrtf(wave_sum(s) * (1.f / DM) + 1e-6f);
    unsigned long long* o8 = (unsigned long long*)orow + lane;
#pragma unroll
    for (int j = 0; j < 8; ++j) { const f32x4 gg = gr[64 * j];
        o8[64 * j] = (unsigned long long)pk2(v[j].x * r * gg.x, v[j].y * r * gg.y) | ((unsigned long long)pk2(v[j].z * r * gg.z, v[j].w * r * gg.w) << 32); }
}
__device__ __forceinline__ int t5_bucket(int rel) {
    const int n = rel < 0 ? -rel : rel; int bk = rel > 0 ? 16 : 0;
    if (n < 8) return bk + n;
    const int large = 8 + (n >= 12) + (n >= 16) + (n >= 23) + (n >= 32) + (n >= 46) + (n >= 64) + (n >= 91);
    return bk + large;
}

struct Args { const float* in[13]; float* out; unsigned char* ws; };
__global__ void __launch_bounds__(NWAVES * 64, 2) mixer_fwd(Args args) {
    extern __shared__ __attribute__((aligned(16))) unsigned char lds[];
    cg::grid_group grid = cg::this_grid();
    const int tid = threadIdx.x, lane = tid & 63, wave = __builtin_amdgcn_readfirstlane(tid >> 6);
    const int G = gridDim.x, bx = blockIdx.x; const int vcu = (G % 8 == 0) ? (bx % 8) * (G / 8) + bx / 8 : bx;
    unsigned char* ws = args.ws;
    const float* xp = args.in[0]; const float* xs = args.in[1];
    bf16* Win_t = (bf16*)(ws + WS_WIN); bf16* Wout_t = (bf16*)(ws + WS_WOUT);
    bf16* XN = (bf16*)args.out;
    bf16* QA = (bf16*)(ws + WS_QA); bf16* KVA = (bf16*)(ws + WS_KVA); bf16* QKVB = (bf16*)(ws + WS_QKVB); bf16* GB = (bf16*)(ws + WS_G);
    float* part = (float*)(ws + WS_PART); float* gtab = (float*)(ws + WS_TAB); float* lamp = (float*)(ws + WS_LAM);

    for (int p0pass = 0; p0pass < (ATT_ABL == 6 ? 2 : 1); ++p0pass) {
        LAS float* scr = (LAS float*)((LAS unsigned char*)lds + wave * 16384);
        const int gw = vcu * NWAVES + wave, NGW = G * NWAVES;
        constexpr int I_IN = (DM / 64) * (NPROJ / 32), I_OUT = (DM / 64) * (DM / 32);
        for (int it = gw; it < I_IN + I_OUT; it += NGW) {
            if (it < I_IN) p0_transpose_item(args.in[3], DM, NPROJ, Win_t, scr, it, lane);
            else p0_transpose_item(args.in[4], DM, DM, Wout_t, scr, it - I_IN, lane);
        }
        for (int m = gw; m < MTOK; m += NGW) rms_row_to_bf16(m < MP ? xp + (size_t)m * DM : xs + (size_t)(m - MP) * DM, args.in[2], XN + (size_t)m * DM, lane);
        for (int i = bx * 512 + tid; i < 24 * att::TABW; i += G * 512) { const int h = i / att::TABW, e = i % att::TABW, rel = e - att::TAB0;
            float v = 0.f;
            { v = args.in[11][t5_bucket(rel) * 24 + h] * 1.4426950408889634f; if (h < 16 && (rel < -128 || rel > 128)) v = -1e30f; }
            gtab[i] = v; }
        if (bx == 0 && wave == 0) { const float a = wave_sum(args.in[6][lane] * args.in[7][lane]), c = wave_sum(args.in[8][lane] * args.in[9][lane]);
            if (lane == 0) lamp[0] = expf(a) - expf(c) + 0.2f; }
    }
    grid.sync();
    {
        pg8::Gemm g{XN, Win_t, MTOK, NPROJ, DM}; pg8::StaticOrder S; S.init(MTOK, NPROJ, G, bx);
        pg8::EpiProj E{QA, KVA, QKVB, GB, att::C2};
        pg8::gemm_phase<pg8::EpiProj, pg8::StaticOrder, true, true>((LAS unsigned char*)lds, g, S, E);
    }
    grid.sync();
    {
        const att::Tensors T{QA, KVA, QKVB, GB, gtab, args.in[5], args.in[10], lamp};
        for (int U = vcu; U < 4096; U += G) {
            const int i = U >> 8, v = U & 255, xcd = v >> 5, j = v & 31;
            int ureq, b, hB, qb;
            if (i < 8) { ureq = 0; const int p = xcd * 8 + i; b = p >> 3; hB = p & 7; qb = j; }
            else { ureq = 1; const int ii = i - 8, p = xcd * 4 + (ii >> 1); b = p >> 3; hB = p & 7; qb = (ii & 1) * 32 + j; }
#if ATT_ABL >= 1 && ATT_ABL <= 4
            att::attn_unit<1>(T, ureq, b, hB, qb, (LAS char*)lds, true);
#endif
            att::attn_unit<1>(T, ureq, b, hB, qb, (LAS char*)lds);
        }
        for (int U = vcu; U < 4096; U += G) {
            int u = (U & 255) * 16 + (U >> 8), ureq, b, kvh, qb;
            if (u < 2048) { ureq = 0; b = u >> 8; kvh = (u >> 6) & 3; qb = u & 63; }
            else { u -= 2048; ureq = 1; b = u >> 9; kvh = (u >> 7) & 3; qb = u & 127; }
#if ATT_ABL == 5
            att::attn_unit<0>(T, ureq, b, kvh, qb, (LAS char*)lds, true);
#endif
            att::attn_unit<0>(T, ureq, b, kvh, qb, (LAS char*)lds);
        }
    }
    grid.sync();
    {
        pg8::Gemm g{GB, Wout_t, MTOK, DM, DM}; pg8::StaticOrder S; S.init(MTOK, DM, G, bx);
        pg8::EpiRes E{xp, xs, (bf16*)(ws + WS_QKVB), part};
        pg8::gemm_phase<pg8::EpiRes, pg8::StaticOrder, true, true>((LAS unsigned char*)lds, g, S, E);
    }
    grid.sync();
    {
        const int gw = vcu * NWAVES + wave, NGW = G * NWAVES; const f32x4* fg = (const f32x4*)args.in[12] + 2 * lane;
        const bf16* zb = (const bf16*)(ws + WS_QKVB);
        for (int m = gw; m < MTOK; m += NGW) {
            const float s = wave_sum(lane < 32 ? part[(size_t)m * 32 + lane] : 0.f);
            const float r = 1.f / sqrtf(s * (1.f / DM) + 1e-6f);
            const v4u* zr = (const v4u*)(zb + (size_t)m * DM) + lane; f32x4* orow = (f32x4*)(args.out + (size_t)m * DM) + 2 * lane;
#pragma unroll
            for (int jj = 0; jj < 4; ++jj) { const v4u z = __builtin_nontemporal_load(zr + 64 * jj); const f32x4 g0 = fg[128 * jj], g1 = fg[128 * jj + 1];
                const f32x4 a = {__uint_as_float(z.x << 16), __uint_as_float(z.x & 0xffff0000u), __uint_as_float(z.y << 16), __uint_as_float(z.y & 0xffff0000u)};
                const f32x4 b = {__uint_as_float(z.z << 16), __uint_as_float(z.z & 0xffff0000u), __uint_as_float(z.w << 16), __uint_as_float(z.w & 0xffff0000u)};
                __builtin_nontemporal_store(a * r * g0, orow + 128 * jj); __builtin_nontemporal_store(b * r * g1, orow + 128 * jj + 1); }
        }
    }
}

extern "C" void kernel_launch(void* const* d_in, const int* in_sizes, int n_in, void* d_out, int out_size, void* d_ws, size_t ws_size, hipStream_t stream) {
    static int grid = 0;
    if (grid == 0) {
        if (n_in != 13 || out_size != MTOK * DM || ws_size < WS_END) { fprintf(stderr, "kernel_launch: unexpected shapes (n_in %d out %d ws %zu)\n", n_in, out_size, ws_size); grid = -1; return; }
        int dev = 0, cus = 0, per_cu = 0;
        hipGetDevice(&dev); hipDeviceGetAttribute(&cus, hipDeviceAttributeMultiprocessorCount, dev);
        if (hipFuncSetAttribute((const void*)mixer_fwd, hipFuncAttributeMaxDynamicSharedMemorySize, LDS_BYTES) != hipSuccess) { fprintf(stderr, "kernel_launch: hipFuncSetAttribute failed\n"); grid = -1; return; }
        hipOccupancyMaxActiveBlocksPerMultiprocessor(&per_cu, (const void*)mixer_fwd, NWAVES * 64, LDS_BYTES);
        (void)hipGetLastError();
        if (per_cu < 1) per_cu = 1;
        grid = cus;
        if (grid != 256) fprintf(stderr, "kernel_launch: note: %d CUs (tuned for 256)\n", grid);
    }
    if (grid < 0) return;
    Args a{};
    for (int i = 0; i < 13; ++i) a.in[i] = (const float*)d_in[i];
    a.out = (float*)d_out; a.ws = (unsigned char*)d_ws;
    void* kargs[] = {&a};
    hipError_t e = hipLaunchCooperativeKernel((const void*)mixer_fwd, dim3(grid), dim3(NWAVES * 64), kargs, LDS_BYTES, stream);
    if (e != hipSuccess) fprintf(stderr, "kernel_launch: cooperative launch failed: %s (grid %d)\n", hipGetErrorString(e), grid);
}
```

```cpp
#include <hip/hip_runtime.h>
#include <hip/hip_cooperative_groups.h>
#include <hip/hip_bf16.h>
#include <cstdio>
#include <cstdint>
#include <cmath>
#define ATT_ABL 0
namespace pg8 {
#define PG8_LAS __attribute__((address_space(3)))
typedef unsigned short bf16_t;
typedef short bf16x8 __attribute__((ext_vector_type(8)));
typedef float f32x4 __attribute__((ext_vector_type(4)));
typedef unsigned u32x4 __attribute__((ext_vector_type(4)));
constexpr int BM = 256, BK = 64, HALF = 128, HTB = HALF * BK * 2  , STAGE_BYTES = 8 * HTB, NXCD = 8, WGM = 8;

__host__ __device__ __forceinline__ int lds_byte(int r, int c) { const int st = (r >> 4) * 2 + (c >> 5), rr = r & 15, cc = c & 31, ob = rr * 64 + cc * 2; return st * 1024 + (ob ^ (((ob >> 9) & 1) << 5)); }
__host__ __device__ __forceinline__ void stage_rc(int b, int& R, int& C) { const int st = b / 1024, sb = b % 1024, swz = sb ^ (((sb >> 9) & 1) << 5); R = (st >> 1) * 16 + swz / 64; C = (st & 1) * 32 + (swz % 64) / 2; }
__host__ __device__ __forceinline__ int perm32(int rho) { const int n = rho >> 4, i = rho & 15; return 8 * (i >> 2) + 4 * n + (i & 3); }

struct Unit { int pm, pn; };
struct Gemm { const bf16_t* A; const bf16_t* Bt; int M, N, K; };

struct StaticOrder {
    int nM, nN, nwg, G, c;
    __host__ __device__ void init(int M, int N, int G_, int c_) { nM = M / BM; nN = N / BM; nwg = nM * nN; G = G_; c = c_; }
    __host__ __device__ bool next(int i, Unit& u) const {
        const long L = (long)i * G + c; if (L >= nwg) return false;
        int wgid = (int)L; { const int q = nwg / NXCD, r = nwg % NXCD, xcd = wgid % NXCD, off = wgid / NXCD; wgid = (xcd < r ? xcd * (q + 1) : r * (q + 1) + (xcd - r) * q) + off; }
        const int nig = WGM * nN, gid = wgid / nig, fm = gid * WGM, gsz = (nM - fm) < WGM ? (nM - fm) : WGM;
        u.pm = fm + ((wgid % nig) % gsz); u.pn = (wgid % nig) / gsz; return true;
    }
    __device__ __forceinline__ void a_ready(const Unit&) const {}
    __device__ __forceinline__ void done(const Unit&) const {}
};
__device__ __forceinline__ unsigned cvt_pk_bf16(float lo, float hi) { unsigned r; asm volatile("v_cvt_pk_bf16_f32 %0, %1, %2" : "=v"(r) : "v"(lo), "v"(hi)); return r; }
typedef float f32x2 __attribute__((ext_vector_type(2)));
struct EpiProj {
    static constexpr bool PERM = true, AFTER_DRAIN = false;
    bf16_t *QA, *KVA, *QKVB, *G; float c2;
    __device__ __forceinline__ void operator()(const f32x4 (&acc)[2][2][4][2], const Unit& u, int wr, int wc, int fr, int fq) const {
        const int row0 = u.pm * BM + wr * 64 + fr; const int colt = u.pn * BM;
        bf16_t* base; int ldc, c0; float sc = 1.f;
        if (colt < 1024)      { base = QA;   ldc = 1024; c0 = colt;        sc = c2; }
        else if (colt < 1536) { base = KVA;  ldc = 512;  c0 = colt - 1024; }
        else if (colt < 2560) { base = G;    ldc = 2048; c0 = colt - 1536; }
        else if (colt < 5632) { base = QKVB; ldc = 3072; c0 = colt - 2560; if (colt < 3584) sc = c2; }
        else                  { base = G;    ldc = 2048; c0 = colt - 5632 + 1024; }
        const int col0 = c0 + wc * 32 + 8 * fq;
#pragma unroll
        for (int ai = 0; ai < 2; ++ai)
#pragma unroll
            for (int m = 0; m < 4; ++m) { bf16_t* rowp = base + (size_t)(row0 + ai * HALF + m * 16) * ldc + col0;
#pragma unroll
                for (int bj = 0; bj < 2; ++bj) { f32x4 v0 = acc[ai][bj][m][0] * sc, v1 = acc[ai][bj][m][1] * sc;
                    u32x4 w; w.x = cvt_pk_bf16(v0[0], v0[1]); w.y = cvt_pk_bf16(v0[2], v0[3]); w.z = cvt_pk_bf16(v1[0], v1[1]); w.w = cvt_pk_bf16(v1[2], v1[3]);
                    *(u32x4*)(rowp + bj * HALF) = w; } }
    }
};
struct EpiRes {
    static constexpr bool PERM = true, AFTER_DRAIN = false;
    const float* xp; const float* xs; bf16_t* zb; float* part;
    __device__ __forceinline__ void operator()(const f32x4 (&acc)[2][2][4][2], const Unit& u, int wr, int wc, int fr, int fq) const {
        const int col0 = u.pn * BM + wc * 32 + 8 * fq;
#pragma unroll
        for (int ai = 0; ai < 2; ++ai)
#pragma unroll
            for (int m = 0; m < 4; ++m) { const int row = u.pm * BM + ai * HALF + wr * 64 + m * 16 + fr;
                const float* xr = (row < 32768 ? xp + (size_t)row * 2048 : xs + (size_t)(row - 32768) * 2048) + col0; bf16_t* zrow = zb + (size_t)row * 2048 + col0;
                float s = 0.f;
#pragma unroll
                for (int bj = 0; bj < 2; ++bj) { const f32x4 v0 = __builtin_nontemporal_load((const f32x4*)(xr + bj * HALF)) + acc[ai][bj][m][0], v1 = __builtin_nontemporal_load((const f32x4*)(xr + bj * HALF + 4)) + acc[ai][bj][m][1];
                    s += ((v0[0] * v0[0] + v0[1] * v0[1]) + (v0[2] * v0[2] + v0[3] * v0[3])) + ((v1[0] * v1[0] + v1[1] * v1[1]) + (v1[2] * v1[2] + v1[3] * v1[3]));
                    u32x4 w; w.x = cvt_pk_bf16(v0[0], v0[1]); w.y = cvt_pk_bf16(v0[2], v0[3]); w.z = cvt_pk_bf16(v1[0], v1[1]); w.w = cvt_pk_bf16(v1[2], v1[3]);
                    *(u32x4*)(zrow + bj * HALF) = w; }
                s += __shfl_xor(s, 16); s += __shfl_xor(s, 32);
                if (fq == 0) part[(size_t)row * 32 + u.pn * 4 + wc] = s; }
    }
};
template <class Epi, class Sched, bool ALIGN_EPI = false, bool SP2 = false>
__device__ __forceinline__ void gemm_phase(PG8_LAS unsigned char* lds, const Gemm g, const Sched& S, const Epi& E) {
    int tid_ = threadIdx.x; asm volatile("" : "+v"(tid_));
    const int tid = tid_, wid = __builtin_amdgcn_readfirstlane(tid >> 6), lane = tid & 63, wr = wid >> 2, wc = wid & 3, fr = lane & 15, fq = lane >> 4;
    const int K = g.K, nt = K / BK;
    unsigned voffA[2], voffB[2];
#pragma unroll
    for (int i = 0; i < 2; ++i) { int R, C; stage_rc(tid * 16 + i * 8192, R, C); const int Rb = Epi::PERM ? ((R & ~31) + perm32(R & 31)) : R;
        voffA[i] = (unsigned)(R * K + C) * 2u; voffB[i] = (unsigned)(Rb * K + C) * 2u; }
    const size_t kstep = (size_t)(BK * 2);
    const size_t hstep = (size_t)HALF * K * 2;
    const size_t tstep = 2 * hstep;
    const unsigned ldsw = (unsigned)wid * 1024u;
    const int aoff = lds_byte(wr * 64 + fr, fq * 8), boff = lds_byte(wc * 32 + fr, fq * 8);
#define PG8_SA(b, h) (((b) * 2 + (h)) * HTB)
#define PG8_SB(b, h) ((4 + (b) * 2 + (h)) * HTB)
#define PG8_STAGE(bufoff, gbase, voff) do { _Pragma("unroll") for (int _i = 0; _i < 2; ++_i) \
        __builtin_amdgcn_global_load_lds((const unsigned*)((const char*)(gbase) + (voff)[_i]), (PG8_LAS unsigned*)(lds + (bufoff) + ldsw + _i * 8192), 16, 0, 0); } while (0)
#define PG8_LDA(dst, b, h) do { _Pragma("unroll") for (int m = 0; m < 4; ++m) _Pragma("unroll") for (int k = 0; k < 2; ++k) dst[m][k] = *(const PG8_LAS bf16x8*)(lds + PG8_SA(b, h) + aoff + m * 2048 + k * 1024); } while (0)
#define PG8_LDB(dst, b, h) do { _Pragma("unroll") for (int n = 0; n < 2; ++n) _Pragma("unroll") for (int k = 0; k < 2; ++k) dst[n][k] = *(const PG8_LAS bf16x8*)(lds + PG8_SB(b, h) + boff + n * 2048 + k * 1024); } while (0)
#define PG8_MMA(ai, bj, At, Bt) do { __builtin_amdgcn_s_setprio(1); _Pragma("unroll") for (int m = 0; m < 4; ++m) _Pragma("unroll") for (int n = 0; n < 2; ++n) _Pragma("unroll") for (int k = 0; k < 2; ++k) \
        acc[ai][bj][m][n] = __builtin_amdgcn_mfma_f32_16x16x32_bf16(Bt[n][k], At[m][k], acc[ai][bj][m][n], 0, 0, 0); __builtin_amdgcn_s_setprio(0); } while (0)
#define PG8_WAIT_V(n) asm volatile("s_waitcnt vmcnt(" #n ")" ::: "memory")
#define PG8_WAIT_L(n) asm volatile("s_waitcnt lgkmcnt(" #n ")" ::: "memory")
#define PG8_BAR __builtin_amdgcn_s_barrier()
#define PG8_SCHED __builtin_amdgcn_sched_barrier(0)
    Unit cur, nxt; int ui = 0;
    if (!S.next(0, cur)) return;
    f32x4 acc[2][2][4][2];
#pragma unroll
    for (int a = 0; a < 2; ++a)
#pragma unroll
        for (int b = 0; b < 2; ++b)
#pragma unroll
            for (int m = 0; m < 4; ++m)
#pragma unroll
                for (int n = 0; n < 2; ++n) acc[a][b][m][n] = (f32x4){0.f, 0.f, 0.f, 0.f};
    bf16x8 At[4][2], B0[2][2], B1[2][2];
    const char* cA = (const char*)g.A + (size_t)cur.pm * tstep; const char* cB = (const char*)g.Bt + (size_t)cur.pn * tstep;
    S.a_ready(cur);
    if constexpr (SP2) {
        PG8_STAGE(PG8_SB(0, 0), cB, voffB); PG8_STAGE(PG8_SB(0, 1), cB + hstep, voffB); PG8_STAGE(PG8_SA(0, 0), cA, voffA); PG8_STAGE(PG8_SA(0, 1), cA + hstep, voffA);
        if (wr == 1) PG8_BAR;
        PG8_WAIT_V(2); PG8_BAR;
        PG8_STAGE(PG8_SB(1, 0), cB + kstep, voffB); PG8_STAGE(PG8_SA(1, 0), cA + kstep, voffA); PG8_STAGE(PG8_SB(1, 1), cB + hstep + kstep, voffB);
        PG8_WAIT_V(6); PG8_BAR;
    } else {
        PG8_STAGE(PG8_SB(0, 0), cB, voffB); PG8_STAGE(PG8_SA(0, 0), cA, voffA); PG8_STAGE(PG8_SB(0, 1), cB + hstep, voffB); PG8_STAGE(PG8_SA(0, 1), cA + hstep, voffA);
        if (wr == 1) PG8_BAR;
        PG8_WAIT_V(4); PG8_BAR;
        PG8_STAGE(PG8_SB(1, 0), cB + kstep, voffB); PG8_STAGE(PG8_SA(1, 0), cA + kstep, voffA); PG8_STAGE(PG8_SB(1, 1), cB + hstep + kstep, voffB);
        PG8_WAIT_V(6); PG8_BAR;
    }
    for (;;) {
        const bool has_next = S.next(ui + 1, nxt);
        const char* nA = has_next ? (const char*)g.A + (size_t)nxt.pm * tstep : cA; const char* nB = has_next ? (const char*)g.Bt + (size_t)nxt.pn * tstep : cB;
        for (int t = 0; t < nt; t += 2) {
            const bool last = (t == nt - 2);
            const char* a1 = cA + (size_t)(t + 1) * kstep;
            const char* a2 = last ? nA : cA + (size_t)(t + 2) * kstep; const char* b2 = last ? nB : cB + (size_t)(t + 2) * kstep;
            const char* a3 = a2 + kstep; const char* b3 = b2 + kstep;
            if (last && has_next) S.a_ready(nxt);
            if constexpr (SP2) {
            PG8_LDB(B0, 0, 0); PG8_LDB(B1, 0, 1); PG8_SCHED; PG8_LDA(At, 0, 0); PG8_STAGE(PG8_SA(1, 1), a1 + hstep, voffA);
            PG8_WAIT_V(8); PG8_WAIT_L(0); PG8_BAR; PG8_MMA(0, 0, At, B0); PG8_MMA(0, 1, At, B1); PG8_BAR; PG8_SCHED;
            PG8_LDA(At, 0, 1); PG8_STAGE(PG8_SB(0, 0), b2, voffB); PG8_STAGE(PG8_SB(0, 1), b2 + hstep, voffB); PG8_STAGE(PG8_SA(0, 0), a2, voffA);
            PG8_WAIT_V(8); PG8_WAIT_L(0); PG8_BAR; PG8_MMA(1, 0, At, B0); PG8_MMA(1, 1, At, B1); PG8_BAR; PG8_SCHED;
            PG8_LDB(B0, 1, 0); PG8_LDB(B1, 1, 1); PG8_SCHED; PG8_LDA(At, 1, 0); PG8_STAGE(PG8_SA(0, 1), a2 + hstep, voffA);
            PG8_WAIT_V(8); PG8_WAIT_L(0); PG8_BAR; PG8_MMA(0, 0, At, B0); PG8_MMA(0, 1, At, B1); PG8_BAR; PG8_SCHED;
            PG8_LDA(At, 1, 1); PG8_STAGE(PG8_SB(1, 0), b3, voffB); PG8_STAGE(PG8_SB(1, 1), b3 + hstep, voffB); PG8_STAGE(PG8_SA(1, 0), a3, voffA);
            PG8_WAIT_V(8); PG8_WAIT_L(0); PG8_BAR; PG8_MMA(1, 0, At, B0); PG8_MMA(1, 1, At, B1); PG8_BAR; PG8_SCHED;
            } else {
            PG8_LDB(B0, 0, 0); PG8_SCHED; PG8_LDA(At, 0, 0); PG8_STAGE(PG8_SA(1, 1), a1 + hstep, voffA);
            PG8_WAIT_L(8); PG8_BAR; PG8_WAIT_L(0); PG8_MMA(0, 0, At, B0); PG8_BAR; PG8_SCHED;
            PG8_LDB(B1, 0, 1); PG8_STAGE(PG8_SB(0, 0), b2, voffB);
            PG8_BAR; PG8_WAIT_L(0); PG8_MMA(0, 1, At, B1); PG8_BAR;
            PG8_LDA(At, 0, 1); PG8_STAGE(PG8_SA(0, 0), a2, voffA);
            PG8_BAR; PG8_WAIT_L(0); PG8_MMA(1, 0, At, B0); PG8_BAR; PG8_SCHED;
            PG8_STAGE(PG8_SB(0, 1), b2 + hstep, voffB);
            PG8_WAIT_V(6); PG8_BAR; PG8_MMA(1, 1, At, B1); PG8_BAR;
            PG8_LDB(B0, 1, 0); PG8_SCHED; PG8_LDA(At, 1, 0); PG8_STAGE(PG8_SA(0, 1), a2 + hstep, voffA);
            PG8_WAIT_L(8); PG8_BAR; PG8_WAIT_L(0); PG8_MMA(0, 0, At, B0); PG8_BAR; PG8_SCHED;
            PG8_LDB(B1, 1, 1); PG8_STAGE(PG8_SB(1, 0), b3, voffB);
            PG8_BAR; PG8_WAIT_L(0); PG8_MMA(0, 1, At, B1); PG8_BAR;
            PG8_LDA(At, 1, 1); PG8_STAGE(PG8_SA(1, 0), a3, voffA);
            PG8_BAR; PG8_WAIT_L(0); PG8_MMA(1, 0, At, B0); PG8_BAR; PG8_SCHED;
            PG8_STAGE(PG8_SB(1, 1), b3 + hstep, voffB);
            PG8_WAIT_V(6); PG8_BAR; PG8_MMA(1, 1, At, B1); PG8_BAR;
            }
        }
        if constexpr (ALIGN_EPI) { if (wr == 0) PG8_BAR; }
        if constexpr (!Epi::AFTER_DRAIN) { E(acc, cur, wr, wc, fr, fq); S.done(cur); }
        if (!has_next) break;
#pragma unroll
        for (int a = 0; a < 2; ++a)
#pragma unroll
            for (int b = 0; b < 2; ++b)
#pragma unroll
                for (int m = 0; m < 4; ++m)
#pragma unroll
                    for (int n = 0; n < 2; ++n) acc[a][b][m][n] = (f32x4){0.f, 0.f, 0.f, 0.f};
        cur = nxt; cA = nA; cB = nB; ++ui;
        if constexpr (ALIGN_EPI) { if (wr == 1) PG8_BAR; }
    }
    PG8_WAIT_V(0);
    if constexpr (!ALIGN_EPI) { if (wr == 0) PG8_BAR; }
    PG8_BAR;
    if constexpr (Epi::AFTER_DRAIN) { E.fused(acc, cur, wr, wc, fr, fq, lds, wid, lane); S.done(cur); }
#undef PG8_SA
#undef PG8_SB
#undef PG8_STAGE
#undef PG8_LDA
#undef PG8_LDB
#undef PG8_MMA
#undef PG8_WAIT_V
#undef PG8_WAIT_L
#undef PG8_BAR
#undef PG8_SCHED
}
}
namespace att {
#define LAS3 __attribute__((address_space(3)))
typedef LAS3 const char* lds_cptr;
typedef unsigned short bf16_t;
using bf16x8 = __attribute__((ext_vector_type(8))) short;
using s16x4 = __attribute__((ext_vector_type(4))) short;
using f32x16 = __attribute__((ext_vector_type(16))) float;
using u32x4 = __attribute__((ext_vector_type(4))) unsigned;
typedef short v4i16_t __attribute__((ext_vector_type(4)));
constexpr int SLOTB = 32768, NSLOT = 4, OFF_K2 = 8192, OFF_V = 16384;
constexpr int LDS_WS = NSLOT * SLOTB;
constexpr int LDS_TAB = LDS_WS + 2048;
constexpr int LDS_END = LDS_TAB + 9216;
constexpr int TABW = 576, TAB0 = 288;
constexpr float LOG2E = 1.4426950408889634f;
constexpr float C2 = 0.125f * LOG2E;
constexpr float THRL = 8.0f;
__device__ __forceinline__ int crow(int r, int hi) { return (r & 3) + 8 * (r >> 2) + 4 * hi; }
__device__ __forceinline__ void glds16(const void* gsrc, unsigned lds_dst) { unsigned keep;
  asm volatile("s_mov_b32 %0, m0\n\ts_mov_b32 m0, %2\n\ts_nop 0\n\tglobal_load_lds_dwordx4 %1, off\n\ts_mov_b32 m0, %0" : "=&s"(keep) : "v"(gsrc), "s"(lds_dst) : "memory"); }
typedef float f32x2_t __attribute__((ext_vector_type(2))); typedef __bf16 bf16x2_t __attribute__((ext_vector_type(2)));
__device__ __forceinline__ unsigned cvtpk(float lo, float hi) { f32x2_t v = {lo, hi}; bf16x2_t b = __builtin_convertvector(v, bf16x2_t); return __builtin_bit_cast(unsigned, b); }
__device__ __forceinline__ float bf2f(bf16_t v) { return __uint_as_float((unsigned)v << 16); }
__device__ __forceinline__ bf16_t f2bf(float f) { return (bf16_t)(cvtpk(f, 0.f) & 0xffffu); }
__device__ __forceinline__ float max2f(float a, float b) { float r; asm("v_max_f32_e32 %0, %1, %2" : "=v"(r) : "v"(a), "v"(b)); return r; }
__device__ __forceinline__ float max3f(float a, float b, float c) { float r; asm("v_max3_f32 %0, %1, %2, %3" : "=v"(r) : "v"(a), "v"(b), "v"(c)); return r; }
#define ATT_WAIT_BAR(N) asm volatile("s_waitcnt vmcnt(" #N ") lgkmcnt(0)\n\ts_barrier" ::: "memory")
__device__ __forceinline__ s16x4 vtr(lds_cptr p) { return __builtin_bit_cast(s16x4, __builtin_amdgcn_ds_read_tr16_b64_v4i16((LAS3 v4i16_t*)p)); }

struct Tensors { bf16_t* QA; bf16_t* KVA; bf16_t* QKVB; bf16_t* G; const float* gtab; const float* sink; const float* subg; const float* lamp; };

template <int MODE>
__device__ __forceinline__ void attn_unit(const Tensors& T0, int ureq, int b, int hh, int qblk, LAS3 char* shm, const bool dummy = false) {
  constexpr int ND = MODE ? 4 : 2;
  constexpr int QROWS = MODE ? 128 : 64;
  constexpr int PQ = MODE ? 3072 : 1024, PK = MODE ? 3072 : 512;
  int tid = threadIdx.x; asm volatile("" : "+v"(tid));
  Tensors T = T0;
  asm volatile("" : "+s"(T.QA), "+s"(T.KVA), "+s"(T.QKVB), "+s"(T.G)); asm volatile("" : "+s"(T.gtab), "+s"(T.sink), "+s"(T.subg), "+s"(T.lamp));
  const int lane = tid & 63, r32 = lane & 31, hi = lane >> 5; const int wid = __builtin_amdgcn_readfirstlane(tid >> 6);
  const int S = ureq ? 8192 : 4096;
  const long rowbase = ureq ? 32768 + (long)b * 8192 : (long)b * 4096;
  const int rg = MODE ? (wid & 3) : (wid & 1);
  const int sub = MODE ? (wid >> 2) : (wid >> 1);
  const int Q0 = qblk * QROWS, q0w = Q0 + rg * 32;
  const bf16_t* Qw = MODE ? T.QKVB + (rowbase + q0w) * PQ + hh * 128 + sub * 64 : T.QA + (rowbase + q0w) * PQ + (hh * 4 + sub) * 64;
  const bf16_t* Kh = MODE ? T.QKVB + rowbase * PK + 1024 + hh * 128 : T.KVA + rowbase * PK + hh * 64;
  const bf16_t* Vh = MODE ? T.QKVB + rowbase * PK + 2048 + hh * 128 : T.KVA + rowbase * PK + 256 + hh * 64;
  const unsigned lds0 = (unsigned)(uintptr_t)shm;
  LAS3 float* wsf = (LAS3 float*)(shm + LDS_WS) + wid * 64;
  LAS3 float* tab = (LAS3 float*)(shm + LDS_TAB);
  { const float* gt = T.gtab + (MODE ? (16 + hh) : hh * 4) * TABW; for (int i = tid; i < (MODE ? 1 : 4) * TABW; i += 512) tab[i] = gt[i]; }
  float cbL = 0.f, cbR = 0.f, lam = 0.f, sinkv = 0.f;
  if (MODE) { cbL = T.gtab[(16 + hh) * TABW]; cbR = T.gtab[(16 + hh) * TABW + TABW - 1]; lam = T.lamp[0]; } else { sinkv = T.sink[hh * 4 + sub] * LOG2E; }
  bf16x8 qr[4];
#pragma unroll
  for (int d0 = 0; d0 < 4; ++d0) qr[d0] = *reinterpret_cast<const bf16x8*>(&Qw[(long)r32 * PQ + d0 * 16 + hi * 8]);
  asm volatile("s_waitcnt vmcnt(0)" ::: "memory");
  const int drow = 8 * wid + (lane >> 3);
  const bf16_t* ksrc = Kh + (long)drow * PK + (((lane & 7) ^ ((drow >> 1) & 7)) * 8);
  const bf16_t* vsrc = Vh + (long)drow * PK + ((((lane >> 2) & 1) ^ ((lane >> 4) & 1)) * 32) + (lane & 3) * 8;
  const unsigned dwv = lds0 + wid * 1024;
#define ATT_DMA(t, so) do { const long _o = (long)(t) * 64 * PK; \
    glds16(ksrc + _o, (unsigned)__builtin_amdgcn_readfirstlane(dwv + (so))); \
    if (MODE) glds16(ksrc + 64 + _o, (unsigned)__builtin_amdgcn_readfirstlane(dwv + (so) + OFF_K2)); \
    glds16(vsrc + _o, (unsigned)__builtin_amdgcn_readfirstlane(dwv + (so) + OFF_V)); \
    if (MODE) glds16(vsrc + 64 + _o, (unsigned)__builtin_amdgcn_readfirstlane(dwv + (so) + OFF_V + 8192)); } while (0)
  int t_lo = 0, t_hi = S / 64;
  if (!MODE) { t_lo = (Q0 >= 128 ? Q0 - 128 : 0) / 64; const int e = Q0 + 64 + 128; t_hi = (e < S ? e : S) / 64; }
  const int NT = t_hi - t_lo;
  const int grp = wid >> 2;
  lds_cptr kp[4];
#pragma unroll
  for (int d0 = 0; d0 < 4; ++d0) kp[d0] = (lds_cptr)shm + (MODE ? sub * OFF_K2 : 0) + r32 * 128 + (((2 * d0 + hi) ^ ((r32 >> 1) & 7)) << 4);
  const int vrow = 4 * hi + ((lane & 15) >> 2), vsw = (lane >> 3) & 1;
  const lds_cptr vpe = (lds_cptr)shm + OFF_V + vrow * 128 + vsw * 64 + ((lane >> 4) & 1) * 32 + (lane & 3) * 8;
  const lds_cptr vpo = (lds_cptr)shm + OFF_V + vrow * 128 + (vsw ^ 1) * 64 + ((lane >> 4) & 1) * 32 + (lane & 3) * 8;
  float mhat, l_reg, curcb; bool first; f32x16 o[ND]; f32x16 negm; u32x4 pw[4];
#define ATT_BAR_V(full) do { if (full) { if (MODE) ATT_WAIT_BAR(4); else ATT_WAIT_BAR(2); } else ATT_WAIT_BAR(0); } while (0)
#define ATT_BAR_L() asm volatile("s_waitcnt lgkmcnt(0)\n\ts_barrier" ::: "memory")
#define ATT_SB() __builtin_amdgcn_sched_barrier(0)
#define ATT_VREAD(buf, ks, vso) do { _Pragma("unroll") for (int d0 = 0; d0 < ND; ++d0) { const lds_cptr vq_ = ((d0 & 1) ? vpo : vpe) + (vso) + (d0 >> 1) * 8192 + (ks) * 2048; \
      const s16x4 lo = vtr(vq_), hi4 = vtr(vq_ + 1024); \
      buf[d0] = (bf16x8){lo[0], lo[1], lo[2], lo[3], hi4[0], hi4[1], hi4[2], hi4[3]}; } } while (0)
#define ATT_PVK(buf, ks) do { _Pragma("unroll") for (int d0 = 0; d0 < ND; ++d0) \
      o[d0] = __builtin_amdgcn_mfma_f32_32x32x16_bf16(__builtin_bit_cast(bf16x8, pw[ks]), buf[d0], o[d0], 0, 0, 0); } while (0)
#define ATT_VREAD1(buf, d0, ks, vso) do { const lds_cptr vq_ = (((d0) & 1) ? vpo : vpe) + (vso) + ((d0) >> 1) * 8192 + (ks) * 2048; \
      const s16x4 lo = vtr(vq_), hi4 = vtr(vq_ + 1024); buf[d0] = (bf16x8){lo[0], lo[1], lo[2], lo[3], hi4[0], hi4[1], hi4[2], hi4[3]}; } while (0)
#define ATT_PVK_RD(buf, ks, vp) do { _Pragma("unroll") for (int d0 = 0; d0 < ND; ++d0) { \
      o[d0] = __builtin_amdgcn_mfma_f32_32x32x16_bf16(__builtin_bit_cast(bf16x8, pw[ks]), buf[d0], o[d0], 0, 0, 0); ATT_VREAD1(buf, d0, (ks) + 2, vp); ATT_SB(); } } while (0)
#define ATT_PV_REST(vp) do { ATT_PVK_RD(vA, 0, vp); ATT_PVK_RD(vB, 1, vp); ATT_PVK(vA, 2); ATT_PVK(vB, 3); } while (0)
  bf16x8 vA[ND], vB[ND];
  mhat = MODE ? 0.f : sinkv; l_reg = (!MODE && hi == 0) ? 1.f : 0.f; curcb = 0.f; first = MODE ? true : false;
#pragma unroll
  for (int d = 0; d < ND; ++d) o[d] = f32x16{};
#pragma unroll
  for (int r = 0; r < 16; ++r) negm[r] = -mhat;
#pragma unroll
  for (int j = 0; j < 4; ++j) pw[j] = (u32x4){0u, 0u, 0u, 0u};
  if (!(ATT_ABL == 2 && dummy)) { ATT_DMA(t_lo, 0); ATT_DMA(t_lo + 1, SLOTB); }
  ATT_BAR_V(true);
  if (grp == 1) { if (NT > 2 && !(ATT_ABL == 2 && dummy)) ATT_DMA(t_lo + 2, 2 * SLOTB); ATT_BAR_L(); }
  for (int i = 0; i < NT; ++i) {
    const int t = t_lo + i;
    const int k0 = t * 64;
    float cb = 0.f; bool near = true;
    if (MODE) { if (k0 + 63 - Q0 <= -91) { cb = cbL; near = false; } else if (k0 - (Q0 + 127) >= 91) { cb = cbR; near = false; } }
    if (cb != curcb) { curcb = cb;
#pragma unroll
      for (int r = 0; r < 16; ++r) negm[r] = cb - mhat; }
    f32x16 C0 = negm, C1 = negm;
    if (!(ATT_ABL == 4 && dummy)) { const int kso = (i & 3) * SLOTB; const int vp = ((i - 1) & 3) * SLOTB;
      bf16x8 kf[8];
#pragma unroll
      for (int d0 = 0; d0 < 2; ++d0) { kf[2 * d0] = *(const LAS3 bf16x8*)(kp[d0] + kso); kf[2 * d0 + 1] = *(const LAS3 bf16x8*)(kp[d0] + kso + 4096); }
      if (i > 0) { ATT_VREAD(vB, 1, vp); }
      ATT_SB();
      if (i > 0) { ATT_PVK_RD(vA, 0, vp); }
      C0 = __builtin_amdgcn_mfma_f32_32x32x16_bf16(kf[0], qr[0], negm, 0, 0, 0); C1 = __builtin_amdgcn_mfma_f32_32x32x16_bf16(kf[1], qr[0], negm, 0, 0, 0);
      C0 = __builtin_amdgcn_mfma_f32_32x32x16_bf16(kf[2], qr[1], C0, 0, 0, 0); C1 = __builtin_amdgcn_mfma_f32_32x32x16_bf16(kf[3], qr[1], C1, 0, 0, 0);
      ATT_SB();
#pragma unroll
      for (int d0 = 2; d0 < 4; ++d0) { kf[2 * d0] = *(const LAS3 bf16x8*)(kp[d0] + kso); kf[2 * d0 + 1] = *(const LAS3 bf16x8*)(kp[d0] + kso + 4096); }
      ATT_SB();
      if (i > 0) { ATT_PVK_RD(vB, 1, vp); }
#pragma unroll
      for (int d0 = 2; d0 < 4; ++d0) { C0 = __builtin_amdgcn_mfma_f32_32x32x16_bf16(kf[2 * d0], qr[d0], C0, 0, 0, 0); C1 = __builtin_amdgcn_mfma_f32_32x32x16_bf16(kf[2 * d0 + 1], qr[d0], C1, 0, 0, 0); }
      ATT_SB();
      if (i > 0) { ATT_PVK(vA, 2); ATT_PVK(vB, 3); } }
    asm volatile("" : "+v"(C0), "+v"(C1));
#pragma unroll
    for (int d = 0; d < ND; ++d) asm volatile("" : "+v"(o[d]));
    if (grp == 0) ATT_BAR_L(); else ATT_BAR_V(i + 2 < NT);
    if (i == 0) asm volatile("s_nop 15\n\ts_nop 7" : "+v"(C0), "+v"(C1));
    else asm volatile("" : "+v"(C0), "+v"(C1));
    ATT_VREAD(vA, 0, (i & 3) * SLOTB); ATT_SB();
    if (grp == 0 && i + 2 < NT && !(ATT_ABL == 2 && dummy)) ATT_DMA(t + 2, ((i + 2) & 3) * SLOTB);
    if (grp == 1 && i + 3 < NT && !(ATT_ABL == 2 && dummy)) ATT_DMA(t + 3, ((i + 3) & 3) * SLOTB);
    if (!(ATT_ABL == 3 && dummy)) {
    if (near) {
      const LAS3 float* tp = tab + (MODE ? 0 : sub * TABW) + (k0 - q0w - r32 + 4 * hi + TAB0);
#pragma unroll
      for (int r = 0; r < 16; ++r) { C0[r] += tp[(r & 3) + 8 * (r >> 2)]; C1[r] += tp[(r & 3) + 8 * (r >> 2) + 32]; }
    }
    float rm;
    { float a = max3f(C0[0], C0[1], C1[0]), bq = max3f(C0[2], C0[3], C1[1]); a = max3f(a, C1[2], C1[3]);
#pragma unroll
      for (int r = 4; r < 16; r += 4) { a = max3f(a, C0[r], C0[r + 1]); bq = max3f(bq, C0[r + 2], C0[r + 3]); a = max3f(a, C1[r], C1[r + 1]); bq = max3f(bq, C1[r + 2], C1[r + 3]); }
      a = max2f(a, bq);
      auto rr = __builtin_amdgcn_permlane32_swap(__float_as_uint(a), __float_as_uint(a), false, false);
      rm = max2f(__uint_as_float(rr[0]), __uint_as_float(rr[1])); }
    if (first || __any(rm > THRL)) {
      const float dl = first ? rm : __builtin_fmaxf(rm, 0.f);
      mhat += dl;
#pragma unroll
      for (int r = 0; r < 16; ++r) { C0[r] -= dl; C1[r] -= dl; negm[r] = curcb - mhat; }
      if (!first) {
        const float f = __builtin_amdgcn_exp2f(-dl); l_reg *= f;
        if (hi == 0) wsf[r32] = f;
        asm volatile("s_waitcnt lgkmcnt(0)" ::: "memory");
#pragma unroll
        for (int r = 0; r < 16; ++r) { const float fr_ = wsf[crow(r, hi)];
#pragma unroll
          for (int d = 0; d < ND; ++d) o[d][r] *= fr_; }
      }
      first = false;
    }
    float sacc = 0.f;
#pragma unroll
    for (int r = 0; r < 16; ++r) { C0[r] = __builtin_amdgcn_exp2f(C0[r]); C1[r] = __builtin_amdgcn_exp2f(C1[r]); sacc += C0[r] + C1[r]; }
    l_reg += sacc;
#pragma unroll
    for (int j = 0; j < 4; ++j) { pw[0][j] = cvtpk(C0[2 * j], C0[2 * j + 1]); pw[1][j] = cvtpk(C0[8 + 2 * j], C0[8 + 2 * j + 1]);
                                  pw[2][j] = cvtpk(C1[2 * j], C1[2 * j + 1]); pw[3][j] = cvtpk(C1[8 + 2 * j], C1[8 + 2 * j + 1]); }
    }
    asm volatile("" : "+v"(pw[0]), "+v"(pw[1]), "+v"(pw[2]), "+v"(pw[3]), "+v"(l_reg));
    if (grp == 0) ATT_BAR_V(i + 2 < NT); else if (i + 1 < NT) ATT_BAR_L();
  }
  { const int vp = ((NT - 1) & 3) * SLOTB; ATT_VREAD(vB, 1, vp); ATT_SB(); ATT_PV_REST(vp); }
#undef ATT_VREAD
#undef ATT_PVK
#undef ATT_PV_REST
#undef ATT_VREAD1
#undef ATT_PVK_RD
#undef ATT_SB
#undef ATT_BAR_V
#undef ATT_BAR_L
#undef ATT_DMA
  { auto rr = __builtin_amdgcn_permlane32_swap(__float_as_uint(l_reg), __float_as_uint(l_reg), false, false); l_reg = __uint_as_float(rr[0]) + __uint_as_float(rr[1]); }
  if (hi == 0) wsf[32 + r32] = l_reg;
  asm volatile("s_waitcnt lgkmcnt(0)" ::: "memory");
  float rli[16];
#pragma unroll
  for (int r = 0; r < 16; ++r) rli[r] = 1.0f / wsf[32 + crow(r, hi)];
  if (MODE) {
    bf16_t* const gpb = T.G + (size_t)(rowbase + q0w) * 2048 + 1024 + hh * 128 + r32;
    bf16_t gv[2][16];
    if (sub == 0 && !dummy) {
#pragma unroll
      for (int r = 0; r < 16; ++r) gv[0][r] = gpb[(size_t)crow(r, hi) * 2048]; }
    asm volatile("s_waitcnt lgkmcnt(0)\n\ts_barrier" ::: "memory");
    LAS3 float* X = (LAS3 float*)shm + rg * 4096;
    if (sub == 1) {
#pragma unroll
      for (int d = 0; d < ND; ++d)
#pragma unroll
        for (int r = 0; r < 16; ++r) X[(d * 16 + r) * 64 + lane] = o[d][r] * rli[r] * lam;
    }
    asm volatile("s_waitcnt lgkmcnt(0)\n\ts_barrier" ::: "memory");
    if (sub == 0 && !dummy) {
      float ss[16];
#pragma unroll
      for (int r = 0; r < 16; ++r) { float s = 0.f;
#pragma unroll
        for (int d = 0; d < ND; ++d) { const float v = o[d][r] * rli[r] - X[(d * 16 + r) * 64 + lane]; o[d][r] = v; s += v * v; }
        s += __shfl_xor(s, 1); s += __shfl_xor(s, 2); s += __shfl_xor(s, 4); s += __shfl_xor(s, 8); s += __shfl_xor(s, 16);
        ss[r] = 0.8f / sqrtf(s * (1.0f / 128.0f) + 1e-6f); }
#pragma unroll
      for (int d = 0; d < ND; ++d) { const float gsub = T.subg[d * 32 + r32];
        if (d + 1 < ND) {
#pragma unroll
          for (int r = 0; r < 16; ++r) gv[(d + 1) & 1][r] = gpb[(size_t)crow(r, hi) * 2048 + (d + 1) * 32]; }
#pragma unroll
        for (int r = 0; r < 16; ++r) { const float g = bf2f(gv[d & 1][r]); const float sg = g / (1.0f + __expf(-g));
          gpb[(size_t)crow(r, hi) * 2048 + d * 32] = f2bf(o[d][r] * ss[r] * gsub * sg); } }
    }
  } else if (!dummy) {
    bf16_t* const gpb = T.G + (size_t)(rowbase + q0w) * 2048 + (hh * 4 + sub) * 64 + r32; bf16_t gv[2][16];
#pragma unroll
    for (int d = 0; d < ND; ++d)
#pragma unroll
      for (int r = 0; r < 16; ++r) gv[d][r] = gpb[(size_t)crow(r, hi) * 2048 + d * 32];
#pragma unroll
    for (int d = 0; d < ND; ++d)
#pragma unroll
      for (int r = 0; r < 16; ++r) { const float g = bf2f(gv[d][r]); const float sg = g / (1.0f + __expf(-g));
        gpb[(size_t)crow(r, hi) * 2048 + d * 32] = f2bf(o[d][r] * rli[r] * sg); }
  }
  if (!MODE && dummy) {
#pragma unroll
    for (int d = 0; d < ND; ++d) asm volatile("" :: "v"(o[d]));
    asm volatile("" :: "v"(rli[0]), "v"(rli[15]));
  }
  ATT_WAIT_BAR(0);
}
}
namespace cg = cooperative_groups;
constexpr int NWAVES = 8;
constexpr int DM = 2048, NPROJ = 6656, MTOK = 65536, MP = 32768;
constexpr size_t MiB = 1u << 20;
constexpr size_t WS_LAM = 0, WS_TAB = 4096;
constexpr size_t WS_WIN = 2 * MiB, WS_WOUT = 28 * MiB, WS_PART = 36 * MiB;
constexpr size_t WS_QA = 64 * MiB, WS_KVA = 192 * MiB, WS_QKVB = 256 * MiB, WS_G = 640 * MiB, WS_END = 896 * MiB;
constexpr int LDS_BYTES = 147456;
#define GAS __attribute__((address_space(1)))
#define LAS __attribute__((address_space(3)))
typedef unsigned short bf16;
typedef unsigned v4u __attribute__((ext_vector_type(4)));
typedef float f32x4 __attribute__((ext_vector_type(4)));
#define LDS_WAIT() asm volatile("s_waitcnt lgkmcnt(0)" ::: "memory")
__device__ __forceinline__ unsigned f2bf_rne(float f) { unsigned u = __builtin_bit_cast(unsigned, f); return (u + 0x7fffu + ((u >> 16) & 1u)) >> 16; }
__device__ __forceinline__ unsigned pk2(float lo, float hi) { return f2bf_rne(lo) | (f2bf_rne(hi) << 16); }
__device__ __forceinline__ float wave_sum(float v) {
#pragma unroll
    for (int o = 1; o < 64; o <<= 1) v += __shfl_xor(v, o);
    return v;
}
__device__ __forceinline__ void p0_transpose_item(const float* W, int K, int N, bf16* WT, LAS float* scr, int item, int lane) {
    const int nblk = N / 32, kb = item / nblk, nb = item % nblk, k0 = 64 * kb, n0 = 32 * nb;
#pragma unroll 8
    for (int i = 0; i < 32; ++i) { const int kk = 2 * i + (lane >> 5); scr[kk * 33 + (lane & 31)] = W[(size_t)(k0 + kk) * N + n0 + (lane & 31)]; }
    LDS_WAIT(); asm volatile("" ::: "memory");
    const int c = lane & 7;
#pragma unroll
    for (int j = 0; j < 4; ++j) { const int n = (lane >> 3) + 8 * j; const LAS float* s = scr + (8 * c) * 33 + n;
        v4u o; o.x = pk2(s[0 * 33], s[1 * 33]); o.y = pk2(s[2 * 33], s[3 * 33]); o.z = pk2(s[4 * 33], s[5 * 33]); o.w = pk2(s[6 * 33], s[7 * 33]);
        *(GAS v4u*)(WT + (size_t)(n0 + n) * K + k0 + 8 * c) = o; }
    LDS_WAIT(); asm volatile("" ::: "memory");
}
__device__ __forceinline__ void rms_row_to_bf16(const float* xrow, const float* g, bf16* orow, int lane) {
    const f32x4* xr = (const f32x4*)xrow + lane; const f32x4* gr = (const f32x4*)g + lane;
    f32x4 v[8]; float s = 0.f;
#pragma unroll
    for (int j = 0; j < 8; ++j) { v[j] = __builtin_nontemporal_load(xr + 64 * j); s += (v[j].x * v[j].x + v[j].y * v[j].y) + (v[j].z * v[j].z + v[j].w * v[j].w); }
    const float r = 1.f / sqrtf(wave_sum(s) * (1.f / DM) + 1e-6f);
    unsigned long long* o8 = (unsigned long long*)orow + lane;
#pragma unroll
    for (int j = 0; j < 8; ++j) { const f32x4 gg = gr[64 * j];
        o8[64 * j] = (unsigned long long)pk2(v[j].x * r * gg.x, v[j].y * r * gg.y) | ((unsigned long long)pk2(v[j].z * r * gg.z, v[j].w * r * gg.w) << 32); }
}
__device__ __forceinline__ int t5_bucket(int rel) {
    const int n = rel < 0 ? -rel : rel; int bk = rel > 0 ? 16 : 0;
    if (n < 8) return bk + n;
    const int large = 8 + (n >= 12) + (n >= 16) + (n >= 23) + (n >= 32) + (n >= 46) + (n >= 64) + (n >= 91);
    return bk + large;
}

struct Args { const float* in[13]; float* out; unsigned char* ws; };
__global__ void __launch_bounds__(NWAVES * 64, 2) mixer_fwd(Args args) {
    extern __shared__ __attribute__((aligned(16))) unsigned char lds[];
    cg::grid_group grid = cg::this_grid();
    const int tid = threadIdx.x, lane = tid & 63, wave = __builtin_amdgcn_readfirstlane(tid >> 6);
    const int G = gridDim.x, bx = blockIdx.x; const int vcu = (G % 8 == 0) ? (bx % 8) * (G / 8) + bx / 8 : bx;
    unsigned char* ws = args.ws;
    const float* xp = args.in[0]; const float* xs = args.in[1];
    bf16* Win_t = (bf16*)(ws + WS_WIN); bf16* Wout_t = (bf16*)(ws + WS_WOUT);
    bf16* XN = (bf16*)args.out;
    bf16* QA = (bf16*)(ws + WS_QA); bf16* KVA = (bf16*)(ws + WS_KVA); bf16* QKVB = (bf16*)(ws + WS_QKVB); bf16* GB = (bf16*)(ws + WS_G);
    float* part = (float*)(ws + WS_PART); float* gtab = (float*)(ws + WS_TAB); float* lamp = (float*)(ws + WS_LAM);

    for (int p0pass = 0; p0pass < (ATT_ABL == 6 ? 2 : 1); ++p0pass) {
        LAS float* scr = (LAS float*)((LAS unsigned char*)lds + wave * 16384);
        const int gw = vcu * NWAVES + wave, NGW = G * NWAVES;
        constexpr int I_IN = (DM / 64) * (NPROJ / 32), I_OUT = (DM / 64) * (DM / 32);
        for (int it = gw; it < I_IN + I_OUT; it += NGW) {
            if (it < I_IN) p0_transpose_item(args.in[3], DM, NPROJ, Win_t, scr, it, lane);
            else p0_transpose_item(args.in[4], DM, DM, Wout_t, scr, it - I_IN, lane);
        }
        for (int m = gw; m < MTOK; m += NGW) rms_row_to_bf16(m < MP ? xp + (size_t)m * DM : xs + (size_t)(m - MP) * DM, args.in[2], XN + (size_t)m * DM, lane);
        for (int i = bx * 512 + tid; i < 24 * att::TABW; i += G * 512) { const int h = i / att::TABW, e = i % att::TABW, rel = e - att::TAB0;
            float v = 0.f;
            { v = args.in[11][t5_bucket(rel) * 24 + h] * 1.4426950408889634f; if (h < 16 && (rel < -128 || rel > 128)) v = -1e30f; }
            gtab[i] = v; }
        if (bx == 0 && wave == 0) { const float a = wave_sum(args.in[6][lane] * args.in[7][lane]), c = wave_sum(args.in[8][lane] * args.in[9][lane]);
            if (lane == 0) lamp[0] = expf(a) - expf(c) + 0.2f; }
    }
    grid.sync();
    {
        pg8::Gemm g{XN, Win_t, MTOK, NPROJ, DM}; pg8::StaticOrder S; S.init(MTOK, NPROJ, G, bx);
        pg8::EpiProj E{QA, KVA, QKVB, GB, att::C2};
        pg8::gemm_phase<pg8::EpiProj, pg8::StaticOrder, true, true>((LAS unsigned char*)lds, g, S, E);
    }
    grid.sync();
    {
        const att::Tensors T{QA, KVA, QKVB, GB, gtab, args.in[5], args.in[10], lamp};
        for (int U = vcu; U < 4096; U += G) {
            const int i = U >> 8, v = U & 255, xcd = v >> 5, j = v & 31;
            int ureq, b, hB, qb;
            if (i < 8) { ureq = 0; const int p = xcd * 8 + i; b = p >> 3; hB = p & 7; qb = j; }
            else { ureq = 1; const int ii = i - 8, p = xcd * 4 + (ii >> 1); b = p >> 3; hB = p & 7; qb = (ii & 1) * 32 + j; }
#if ATT_ABL >= 1 && ATT_ABL <= 4
            att::attn_unit<1>(T, ureq, b, hB, qb, (LAS char*)lds, true);
#endif
            att::attn_unit<1>(T, ureq, b, hB, qb, (LAS char*)lds);
        }
        for (int U = vcu; U < 4096; U += G) {
            int u = (U & 255) * 16 + (U >> 8), ureq, b, kvh, qb;
            if (u < 2048) { ureq = 0; b = u >> 8; kvh = (u >> 6) & 3; qb = u & 63; }
            else { u -= 2048; ureq = 1; b = u >> 9; kvh = (u >> 7) & 3; qb = u & 127; }
#if ATT_ABL == 5
            att::attn_unit<0>(T, ureq, b, kvh, qb, (LAS char*)lds, true);
#endif
            att::attn_unit<0>(T, ureq, b, kvh, qb, (LAS char*)lds);
        }
    }
    grid.sync();
    {
        pg8::Gemm g{GB, Wout_t, MTOK, DM, DM}; pg8::StaticOrder S; S.init(MTOK, DM, G, bx);
        pg8::EpiRes E{xp, xs, (bf16*)(ws + WS_QKVB), part};
        pg8::gemm_phase<pg8::EpiRes, pg8::StaticOrder, true, true>((LAS unsigned char*)lds, g, S, E);
    }
    grid.sync();
    {
        const int gw = vcu * NWAVES + wave, NGW = G * NWAVES; const f32x4* fg = (const f32x4*)args.in[12] + 2 * lane;
        const bf16* zb = (const bf16*)(ws + WS_QKVB);
        for (int m = gw; m < MTOK; m += NGW) {
            const float s = wave_sum(lane < 32 ? part[(size_t)m * 32 + lane] : 0.f);
            const float r = 1.f / sqrtf(s * (1.f / DM) + 1e-6f);
            const v4u* zr = (const v4u*)(zb + (size_t)m * DM) + lane; f32x4* orow = (f32x4*)(args.out + (size_t)m * DM) + 2 * lane;
#pragma unroll
            for (int jj = 0; jj < 4; ++jj) { const v4u z = __builtin_nontemporal_load(zr + 64 * jj); const f32x4 g0 = fg[128 * jj], g1 = fg[128 * jj + 1];
                const f32x4 a = {__uint_as_float(z.x << 16), __uint_as_float(z.x & 0xffff0000u), __uint_as_float(z.y << 16), __uint_as_float(z.y & 0xffff0000u)};
                const f32x4 b = {__uint_as_float(z.z << 16), __uint_as_float(z.z & 0xffff0000u), __uint_as_float(z.w << 16), __uint_as_float(z.w & 0xffff0000u)};
                __builtin_nontemporal_store(a * r * g0, orow + 128 * jj); __builtin_nontemporal_store(b * r * g1, orow + 128 * jj + 1); }
        }
    }
}

extern "C" void kernel_launch(void* const* d_in, const int* in_sizes, int n_in, void* d_out, int out_size, void* d_ws, size_t ws_size, hipStream_t stream) {
    static int grid = 0;
    if (grid == 0) {
        if (n_in != 13 || out_size != MTOK * DM || ws_size < WS_END) { fprintf(stderr, "kernel_launch: unexpected shapes (n_in %d out %d ws %zu)\n", n_in, out_size, ws_size); grid = -1; return; }
        int dev = 0, cus = 0, per_cu = 0;
        hipGetDevice(&dev); hipDeviceGetAttribute(&cus, hipDeviceAttributeMultiprocessorCount, dev);
        if (hipFuncSetAttribute((const void*)mixer_fwd, hipFuncAttributeMaxDynamicSharedMemorySize, LDS_BYTES) != hipSuccess) { fprintf(stderr, "kernel_launch: hipFuncSetAttribute failed\n"); grid = -1; return; }
        hipOccupancyMaxActiveBlocksPerMultiprocessor(&per_cu, (const void*)mixer_fwd, NWAVES * 64, LDS_BYTES);
        (void)hipGetLastError();
        if (per_cu < 1) per_cu = 1;
        grid = cus;
        if (grid != 256) fprintf(stderr, "kernel_launch: note: %d CUs (tuned for 256)\n", grid);
    }
    if (grid < 0) return;
    Args a{};
    for (int i = 0; i < 13; ++i) a.in[i] = (const float*)d_in[i];
    a.out = (float*)d_out; a.ws = (unsigned char*)d_ws;
    void* kargs[] = {&a};
    hipError_t e = hipLaunchCooperativeKernel((const void*)mixer_fwd, dim3(grid), dim3(NWAVES * 64), kargs, LDS_BYTES, stream);
    if (e != hipSuccess) fprintf(stderr, "kernel_launch: cooperative launch failed: %s (grid %d)\n", hipGetErrorString(e), grid);
}
```
